# Optimizing an MI355X kernel written in HIP

```python
import math
import jax, jax.numpy as jnp
from jax import lax
import numpy as np

D_MODEL = 2048
BATCH = 2
SEQ = 16384
DEPTH = 2

GRID_W = 64
CTX_LEN = 256
N_MIXERS = 2
N_ATTN_LAYERS = (DEPTH + 1) // 2
N_SSM_LAYERS = DEPTH // 2
N_MOD = 9
N_NORMS = 6
EPS = 1e-6
NEG_INF = -1e30
N_HEADS = 16
N_KV_HEADS = 4
HEAD_DIM = D_MODEL // N_HEADS
GQA_GROUP = N_HEADS // N_KV_HEADS
WINDOW = 128
BLOCK = 128
QKV_DIM = (N_HEADS + 2 * N_KV_HEADS) * HEAD_DIM
ROPE_BASE = 10000.0
ROPE_AXIS_DIM = HEAD_DIM // 2
SSM_GROUP_CH = 16
SSM_GROUPS = D_MODEL // SSM_GROUP_CH
SSM_STATE = 64
SSM_CHUNK = 128
DT_MIN = 1e-3
DT_MAX = 1e-1
D_FF = 5632

kernel_name = "hybrid_swa_s5_macaron_dit"


def rmsnorm(t, g):
    tf = t.astype(jnp.float32)
    tf = tf * lax.rsqrt(jnp.mean(tf * tf, axis=-1, keepdims=True) + EPS)
    return (tf * g.astype(jnp.float32)).astype(t.dtype)


def pre_sublayer(t, g, shift, scale):
    return rmsnorm(t, g) * (1 + scale) + shift


def post_sublayer(t, out, g, gate, weight):
    return t + weight * gate * rmsnorm(out, g)


def swiglu(h, w_in, w_out):
    g, u = jnp.split(h @ w_in, 2, axis=-1)
    return (jax.nn.silu(g) * u) @ w_out


def axial_rope_tables(rows):
    row = jnp.repeat(jnp.arange(rows, dtype=jnp.float32), GRID_W)
    col = jnp.tile(jnp.arange(GRID_W, dtype=jnp.float32), rows)
    inv_freq = ROPE_BASE ** (-jnp.arange(0, ROPE_AXIS_DIM, 2, dtype=jnp.float32) / ROPE_AXIS_DIM)
    ang = jnp.concatenate([row[:, None] * inv_freq, col[:, None] * inv_freq], axis=-1)
    return jnp.cos(ang), jnp.sin(ang)


def apply_axial_rope(t, cos, sin):
    tf = t.astype(jnp.float32)
    half = ROPE_AXIS_DIM // 2
    outs = []
    for a in range(2):
        seg = tf[..., a * ROPE_AXIS_DIM:(a + 1) * ROPE_AXIS_DIM]
        cs = cos[:, None, a * half:(a + 1) * half]
        sn = sin[:, None, a * half:(a + 1) * half]
        x1, x2 = seg[..., :half], seg[..., half:]
        outs += [x1 * cs - x2 * sn, x2 * cs + x1 * sn]
    return jnp.concatenate(outs, axis=-1).astype(t.dtype)


def softmax_with_sink(logits, sink_logit):
    full = jnp.concatenate([logits, jnp.broadcast_to(sink_logit, logits.shape[:-1] + (1,))], axis=-1)
    return jax.nn.softmax(full, axis=-1)[..., :-1]


def band_blocks(t, n_blk):
    b = t.shape[0]
    tb = t.reshape(b, n_blk, BLOCK, t.shape[2], t.shape[3])
    tp = jnp.pad(tb, ((0, 0), (1, 1), (0, 0), (0, 0), (0, 0)))
    return jnp.concatenate([tp[:, :-2], tp[:, 1:-1], tp[:, 2:]], axis=2)


def band_mask(n_blk, seq_len):
    i = jnp.arange(BLOCK)[:, None]
    j = jnp.arange(3 * BLOCK)[None, :]
    rel = j - i
    kpos = (jnp.arange(n_blk)[:, None, None] - 1) * BLOCK + j[None]
    return (rel >= BLOCK - WINDOW) & (rel <= BLOCK + WINDOW) & (kpos >= 0) & (kpos < seq_len)


def windowed_gqa(h_lat, h_ctx, w_in, w_out, sink, cos, sin, need_ctx_out):
    b, seq_len, _ = h_lat.shape
    c_len = h_ctx.shape[1]
    n_blk = seq_len // BLOCK
    scale = HEAD_DIM ** -0.5
    splits = [N_HEADS * HEAD_DIM, (N_HEADS + N_KV_HEADS) * HEAD_DIM]
    q, k, v = jnp.split(h_lat @ w_in, splits, axis=-1)
    q = apply_axial_rope(q.reshape(b, seq_len, N_HEADS, HEAD_DIM), cos, sin) * scale
    k = apply_axial_rope(k.reshape(b, seq_len, N_KV_HEADS, HEAD_DIM), cos, sin)
    v = v.reshape(b, seq_len, N_KV_HEADS, HEAD_DIM)
    qc, kc, vc = jnp.split(h_ctx @ w_in, splits, axis=-1)
    kc = kc.reshape(b, c_len, N_KV_HEADS, HEAD_DIM)
    vc = vc.reshape(b, c_len, N_KV_HEADS, HEAD_DIM)
    sink_logit = sink.astype(jnp.float32).reshape(N_KV_HEADS, GQA_GROUP, 1, 1)
    qb = q.reshape(b, n_blk, BLOCK, N_KV_HEADS, GQA_GROUP, HEAD_DIM)
    kb, vb = band_blocks(k, n_blk), band_blocks(v, n_blk)
    s_band = jnp.einsum('bnqhgd,bnkhd->bnhgqk', qb, kb).astype(jnp.float32)
    s_band = jnp.where(band_mask(n_blk, seq_len)[None, :, None, None], s_band, NEG_INF)
    s_ctx = jnp.einsum('bnqhgd,bchd->bnhgqc', qb, kc).astype(jnp.float32)
    p = softmax_with_sink(jnp.concatenate([s_band, s_ctx], axis=-1), sink_logit).astype(v.dtype)
    nb = 3 * BLOCK
    o = (jnp.einsum('bnhgqk,bnkhd->bnqhgd', p[..., :nb], vb)
         + jnp.einsum('bnhgqc,bchd->bnqhgd', p[..., nb:], vc))
    out_lat = o.reshape(b, seq_len, D_MODEL) @ w_out
    out_ctx = None
    if need_ctx_out:
        qc = qc.reshape(b, c_len, N_KV_HEADS, GQA_GROUP, HEAD_DIM) * scale
        s = jnp.einsum('bqhgd,bkhd->bhgqk', qc, kc).astype(jnp.float32)
        pc = softmax_with_sink(s, sink_logit).astype(vc.dtype)
        out_ctx = jnp.einsum('bhgqk,bkhd->bqhgd', pc, vc).reshape(b, c_len, D_MODEL) @ w_out
    return out_lat, out_ctx


def zoh_discretise(a_re, a_im, log_dt, b_re, b_im):
    a_re, a_im = a_re.astype(jnp.float32), a_im.astype(jnp.float32)
    b_re, b_im = b_re.astype(jnp.float32), b_im.astype(jnp.float32)
    dt = jnp.exp(log_dt.astype(jnp.float32))[:, None]
    mag = jnp.exp(a_re * dt)
    ab_re, ab_im = mag * jnp.cos(a_im * dt), mag * jnp.sin(a_im * dt)
    den = a_re * a_re + a_im * a_im
    x_re, x_im = ab_re - 1.0, ab_im
    f_re = ((x_re * a_re + x_im * a_im) / den)[..., None]
    f_im = ((x_im * a_re - x_re * a_im) / den)[..., None]
    bb_re = f_re * b_re - f_im * b_im
    bb_im = f_re * b_im + f_im * b_re
    return ab_re, ab_im, bb_re, bb_im


def _ssm_combine(e_i, e_j):
    ai_re, ai_im, bi_re, bi_im = e_i
    aj_re, aj_im, bj_re, bj_im = e_j
    return (aj_re * ai_re - aj_im * ai_im,
            aj_re * ai_im + aj_im * ai_re,
            aj_re * bi_re - aj_im * bi_im + bj_re,
            aj_re * bi_im + aj_im * bi_re + bj_im)


def s5_scan(u, h0_re, h0_im, disc, c_re, c_im):
    ab_re, ab_im, bb_re, bb_im = disc
    t_len = u.shape[0]
    uc = u.reshape((t_len // SSM_CHUNK, SSM_CHUNK) + u.shape[1:])
    a_re = jnp.broadcast_to(ab_re, (SSM_CHUNK, 1) + ab_re.shape)
    a_im = jnp.broadcast_to(ab_im, (SSM_CHUNK, 1) + ab_im.shape)

    def step(carry, u_blk):
        h_re, h_im = carry
        bu_re = jnp.einsum('tbgc,gpc->tbgp', u_blk, bb_re)
        bu_im = jnp.einsum('tbgc,gpc->tbgp', u_blk, bb_im)
        bu_re = bu_re.at[0].add(ab_re * h_re - ab_im * h_im)
        bu_im = bu_im.at[0].add(ab_re * h_im + ab_im * h_re)
        _, _, s_re, s_im = lax.associative_scan(_ssm_combine, (a_re, a_im, bu_re, bu_im), axis=0)
        y = jnp.einsum('tbgp,gcp->tbgc', s_re, c_re) - jnp.einsum('tbgp,gcp->tbgc', s_im, c_im)
        return (s_re[-1], s_im[-1]), y

    (h_re, h_im), y = lax.scan(step, (h0_re, h0_im), uc)
    return y.reshape(u.shape), h_re, h_im


def s5_mixer(h_lat, h_ctx, w_in, a_re, a_im, log_dt, b_re, b_im, c_re, c_im, d_skip, w_glu, need_ctx_out):
    b = h_lat.shape[0]

    def to_groups(h):
        u = (h @ w_in).astype(jnp.float32)
        t_len = u.shape[1]
        return u, jnp.transpose(u.reshape(b, t_len, SSM_GROUPS, SSM_GROUP_CH), (1, 0, 2, 3))

    u_lat, ut_lat = to_groups(h_lat)
    u_ctx, ut_ctx = to_groups(h_ctx)
    zero = jnp.zeros((b, SSM_GROUPS, SSM_STATE), jnp.float32)
    ys_lat, ys_ctx = [], []
    for dr in range(2):
        disc = zoh_discretise(a_re[dr], a_im[dr], log_dt[dr], b_re[dr], b_im[dr])
        cr, ci = c_re[dr].astype(jnp.float32), c_im[dr].astype(jnp.float32)
        uc = ut_ctx[::-1] if dr == 1 else ut_ctx
        ul = ut_lat[::-1] if dr == 1 else ut_lat
        yc, hr, hi = s5_scan(uc, zero, zero, disc, cr, ci)
        yl, _, _ = s5_scan(ul, hr, hi, disc, cr, ci)
        ys_ctx.append(yc[::-1] if dr == 1 else yc)
        ys_lat.append(yl[::-1] if dr == 1 else yl)

    def readout(y_t, u):
        t_len = u.shape[1]
        y = jnp.transpose(y_t, (1, 0, 2, 3)).reshape(b, t_len, D_MODEL) + d_skip.astype(jnp.float32) * u
        g = jax.nn.gelu(y).astype(h_lat.dtype)
        val, gate = jnp.split(g @ w_glu, 2, axis=-1)
        return val * jax.nn.sigmoid(gate)

    out_lat = readout(ys_lat[0] + ys_lat[1], u_lat)
    out_ctx = readout(ys_ctx[0] + ys_ctx[1], u_ctx) if need_ctx_out else None
    return out_lat, out_ctx


def setup_inputs(seed: int = 0) -> dict:
    key = jax.random.key(seed)
    ks = jax.random.split(key, 24)
    f32 = jnp.float32
    d, f = D_MODEL, D_FF
    na, ns = N_ATTN_LAYERS, N_SSM_LAYERS
    g, p, gc = SSM_GROUPS, SSM_STATE, SSM_GROUP_CH
    nrm = lambda k, shape, s: jax.random.normal(k, shape, f32) * s
    a_im_base = jnp.pi * jnp.arange(p, dtype=f32)
    return {
        "x": nrm(ks[0], (BATCH, SEQ, d), 1.0),
        "c": nrm(ks[1], (BATCH, d), 1.0),
        "ctx": nrm(ks[2], (BATCH, CTX_LEN, d), 1.0),
        "c_ctx": nrm(ks[3], (d,), 1.0),
        "ada_w": nrm(ks[4], (DEPTH, d, N_MOD * d), 0.5 * d ** -0.5),
        "ada_b": nrm(ks[5], (DEPTH, N_MOD * d), 0.02),
        "norm_g": 1.0 + nrm(ks[6], (DEPTH, N_NORMS, d), 0.02),
        "ffn_w_in": nrm(ks[7], (DEPTH, 2, d, 2 * f), d ** -0.5),
        "ffn_w_out": nrm(ks[8], (DEPTH, 2, f, d), f ** -0.5),
        "attn_w_in": nrm(ks[9], (na, d, QKV_DIM), d ** -0.5),
        "attn_w_out": nrm(ks[10], (na, d, d), d ** -0.5),
        "attn_sink": nrm(ks[11], (na, N_HEADS), 0.5),
        "ssm_w_in": nrm(ks[12], (ns, d, d), d ** -0.5),
        "ssm_a_re": -0.5 + nrm(ks[13], (ns, 2, g, p), 0.01),
        "ssm_a_im": a_im_base + nrm(ks[14], (ns, 2, g, p), 0.01),
        "ssm_log_dt": jax.random.uniform(ks[15], (ns, 2, g), f32, math.log(DT_MIN), math.log(DT_MAX)),
        "ssm_b_re": nrm(ks[16], (ns, 2, g, p, gc), (2 * gc) ** -0.5),
        "ssm_b_im": nrm(ks[17], (ns, 2, g, p, gc), (2 * gc) ** -0.5),
        "ssm_c_re": nrm(ks[18], (ns, 2, g, gc, p), (2 * p) ** -0.5),
        "ssm_c_im": nrm(ks[19], (ns, 2, g, gc, p), (2 * p) ** -0.5),
        "ssm_d": nrm(ks[20], (ns, d), 1.0),
        "ssm_w_glu": nrm(ks[21], (ns, d, 2 * d), d ** -0.5),
    }


def reference(x, c, ctx, c_ctx, ada_w, ada_b, norm_g, ffn_w_in, ffn_w_out,
              attn_w_in, attn_w_out, attn_sink,
              ssm_w_in, ssm_a_re, ssm_a_im, ssm_log_dt, ssm_b_re, ssm_b_im,
              ssm_c_re, ssm_c_im, ssm_d, ssm_w_glu):
    seq_len = x.shape[1]
    ROWS = seq_len // GRID_W
    cos, sin = axial_rope_tables(ROWS)
    c_act = jax.nn.silu(c)
    cc_act = jax.nn.silu(c_ctx)
    for i in range(DEPTH):
        need_ctx = i < DEPTH - 1
        mx = jnp.split((c_act @ ada_w[i] + ada_b[i])[:, None, :], N_MOD, axis=-1)
        mc = jnp.split((cc_act @ ada_w[i] + ada_b[i])[None, None, :], N_MOD, axis=-1)
        g = norm_g[i]
        x = post_sublayer(x, swiglu(pre_sublayer(x, g[0], mx[0], mx[1]), ffn_w_in[i, 0], ffn_w_out[i, 0]), g[1], mx[2], 0.5)
        ctx = post_sublayer(ctx, swiglu(pre_sublayer(ctx, g[0], mc[0], mc[1]), ffn_w_in[i, 0], ffn_w_out[i, 0]), g[1], mc[2], 0.5)
        hx = pre_sublayer(x, g[2], mx[3], mx[4])
        hc = pre_sublayer(ctx, g[2], mc[3], mc[4])
        j = i // N_MIXERS
        if i % N_MIXERS == 0:
            ox, oc = windowed_gqa(hx, hc, attn_w_in[j], attn_w_out[j], attn_sink[j], cos, sin, need_ctx)
        else:
            ox, oc = s5_mixer(hx, hc, ssm_w_in[j], ssm_a_re[j], ssm_a_im[j], ssm_log_dt[j],
                              ssm_b_re[j], ssm_b_im[j], ssm_c_re[j], ssm_c_im[j], ssm_d[j], ssm_w_glu[j], need_ctx)
        x = post_sublayer(x, ox, g[3], mx[5], 1.0)
        x = post_sublayer(x, swiglu(pre_sublayer(x, g[4], mx[6], mx[7]), ffn_w_in[i, 1], ffn_w_out[i, 1]), g[5], mx[8], 0.5)
        if need_ctx:
            ctx = post_sublayer(ctx, oc, g[3], mc[5], 1.0)
            ctx = post_sublayer(ctx, swiglu(pre_sublayer(ctx, g[4], mc[6], mc[7]), ffn_w_in[i, 1], ffn_w_out[i, 1]), g[5], mc[8], 0.5)
    return x
```

```cpp
#include <hip/hip_runtime.h>
#include <cstdio>
#include <cstdint>
namespace pg8 {
#define PG8_LAS __attribute__((address_space(3)))
typedef unsigned short bf16_t;
typedef short bf16x8 __attribute__((ext_vector_type(8)));
typedef float f32x4 __attribute__((ext_vector_type(4)));
typedef unsigned u32x4 __attribute__((ext_vector_type(4)));
constexpr int BM = 256, BK = 64, HALF = 128, HTB = HALF * BK * 2  , STAGE_BYTES = 8 * HTB, NXCD = 8, WGM = 8;

__host__ __device__ __forceinline__ int lds_byte(int r, int c) { const int st = (r >> 4) * 2 + (c >> 5), rr = r & 15, cc = c & 31, ob = rr * 64 + cc * 2; return st * 1024 + (ob ^ (((ob >> 9) & 1) << 5)); }
__host__ __device__ __forceinline__ void stage_rc(int b, int& R, int& C) { const int st = b / 1024, sb = b % 1024, swz = sb ^ (((sb >> 9) & 1) << 5); R = (st >> 1) * 16 + swz / 64; C = (st & 1) * 32 + (swz % 64) / 2; }
__host__ __device__ __forceinline__ int perm32(int rho) { const int n = rho >> 4, i = rho & 15; return 8 * (i >> 2) + 4 * n + (i & 3); }

struct Unit { int pm, pn; };
struct Gemm { const bf16_t* A; const bf16_t* Bt; int M, N, K; };

struct StaticOrder {
    int nM, nN, nwg, G, c;
    __host__ __device__ void init(int M, int N, int G_, int c_) { nM = M / BM; nN = N / BM; nwg = nM * nN; G = G_; c = c_; }
    __host__ __device__ bool next(int i, Unit& u) const {
        const long L = (long)i * G + c; if (L >= nwg) return false;
        int wgid = (int)L; { const int q = nwg / NXCD, r = nwg % NXCD, xcd = wgid % NXCD, off = wgid / NXCD; wgid = (xcd < r ? xcd * (q + 1) : r * (q + 1) + (xcd - r) * q) + off; }
        const int nig = WGM * nN, gid = wgid / nig, fm = gid * WGM, gsz = (nM - fm) < WGM ? (nM - fm) : WGM;
        u.pm = fm + ((wgid % nig) % gsz); u.pn = (wgid % nig) / gsz; return true;
    }
    __device__ __forceinline__ void a_ready(const Unit&) const {}
    __device__ __forceinline__ void done(const Unit&) const {}
};

__device__ __forceinline__ unsigned cvt_pk_bf16(float lo, float hi) { unsigned r; asm volatile("v_cvt_pk_bf16_f32 %0, %1, %2" : "=v"(r) : "v"(lo), "v"(hi)); return r; }

template <class Epi, class Sched, bool ALIGN_EPI = false, bool SP2 = false>
__device__ __forceinline__ void gemm_phase(PG8_LAS unsigned char* lds, const Gemm g, const Sched& S, const Epi& E) {
    const int tid = threadIdx.x, wid = __builtin_amdgcn_readfirstlane(tid >> 6), lane = tid & 63, wr = wid >> 2, wc = wid & 3, fr = lane & 15, fq = lane >> 4;
    const int K = g.K, nt = K / BK;
    unsigned voffA[2], voffB[2];
#pragma unroll
    for (int i = 0; i < 2; ++i) { int R, C; stage_rc(tid * 16 + i * 8192, R, C); const int Rb = Epi::PERM ? ((R & ~31) + perm32(R & 31)) : R;
        voffA[i] = (unsigned)(R * K + C) * 2u; voffB[i] = (unsigned)(Rb * K + C) * 2u; }
    const size_t kstep = (size_t)(BK * 2);
    const size_t hstep = (size_t)HALF * K * 2;
    const size_t tstep = 2 * hstep;
    const unsigned ldsw = (unsigned)wid * 1024u;
    const int aoff = lds_byte(wr * 64 + fr, fq * 8), boff = lds_byte(wc * 32 + fr, fq * 8);
#define PG8_SA(b, h) (((b) * 2 + (h)) * HTB)
#define PG8_SB(b, h) ((4 + (b) * 2 + (h)) * HTB)
#define PG8_STAGE(bufoff, gbase, voff) do { _Pragma("unroll") for (int _i = 0; _i < 2; ++_i) \
        __builtin_amdgcn_global_load_lds((const unsigned*)((const char*)(gbase) + (voff)[_i]), (PG8_LAS unsigned*)(lds + (bufoff) + ldsw + _i * 8192), 16, 0, 0); } while (0)
#define PG8_LDA(dst, b, h) do { _Pragma("unroll") for (int m = 0; m < 4; ++m) _Pragma("unroll") for (int k = 0; k < 2; ++k) dst[m][k] = *(const PG8_LAS bf16x8*)(lds + PG8_SA(b, h) + aoff + m * 2048 + k * 1024); } while (0)
#define PG8_LDB(dst, b, h) do { _Pragma("unroll") for (int n = 0; n < 2; ++n) _Pragma("unroll") for (int k = 0; k < 2; ++k) dst[n][k] = *(const PG8_LAS bf16x8*)(lds + PG8_SB(b, h) + boff + n * 2048 + k * 1024); } while (0)
#define PG8_MMA(ai, bj, At, Bt) do { __builtin_amdgcn_s_setprio(1); _Pragma("unroll") for (int m = 0; m < 4; ++m) _Pragma("unroll") for (int n = 0; n < 2; ++n) _Pragma("unroll") for (int k = 0; k < 2; ++k) \
        acc[ai][bj][m][n] = __builtin_amdgcn_mfma_f32_16x16x32_bf16(Bt[n][k], At[m][k], acc[ai][bj][m][n], 0, 0, 0); __builtin_amdgcn_s_setprio(0); } while (0)
#define PG8_WAIT_V(n) asm volatile("s_waitcnt vmcnt(" #n ")" ::: "memory")
#define PG8_WAIT_L(n) asm volatile("s_waitcnt lgkmcnt(" #n ")" ::: "memory")
#define PG8_BAR __builtin_amdgcn_s_barrier()
#define PG8_SCHED __builtin_amdgcn_sched_barrier(0)
    Unit cur, nxt; int ui = 0;
    if (!S.next(0, cur)) return;
    f32x4 acc[2][2][4][2];
#pragma unroll
    for (int a = 0; a < 2; ++a)
#pragma unroll
        for (int b = 0; b < 2; ++b)
#pragma unroll
            for (int m = 0; m < 4; ++m)
#pragma unroll
                for (int n = 0; n < 2; ++n) acc[a][b][m][n] = (f32x4){0.f, 0.f, 0.f, 0.f};
    bf16x8 At[4][2], B0[2][2], B1[2][2];
    const char* cA = (const char*)g.A + (size_t)cur.pm * tstep; const char* cB = (const char*)g.Bt + (size_t)cur.pn * tstep;
    S.a_ready(cur);
    if constexpr (SP2) {
        PG8_STAGE(PG8_SB(0, 0), cB, voffB); PG8_STAGE(PG8_SB(0, 1), cB + hstep, voffB); PG8_STAGE(PG8_SA(0, 0), cA, voffA); PG8_STAGE(PG8_SA(0, 1), cA + hstep, voffA);
        if (wr == 1) PG8_BAR;
        PG8_WAIT_V(2); PG8_BAR;
        PG8_STAGE(PG8_SB(1, 0), cB + kstep, voffB); PG8_STAGE(PG8_SA(1, 0), cA + kstep, voffA); PG8_STAGE(PG8_SB(1, 1), cB + hstep + kstep, voffB);
        PG8_WAIT_V(6); PG8_BAR;
    } else {
        PG8_STAGE(PG8_SB(0, 0), cB, voffB); PG8_STAGE(PG8_SA(0, 0), cA, voffA); PG8_STAGE(PG8_SB(0, 1), cB + hstep, voffB); PG8_STAGE(PG8_SA(0, 1), cA + hstep, voffA);
        if (wr == 1) PG8_BAR;
        PG8_WAIT_V(4); PG8_BAR;
        PG8_STAGE(PG8_SB(1, 0), cB + kstep, voffB); PG8_STAGE(PG8_SA(1, 0), cA + kstep, voffA); PG8_STAGE(PG8_SB(1, 1), cB + hstep + kstep, voffB);
        PG8_WAIT_V(6); PG8_BAR;
    }
    for (;;) {
        const bool has_next = S.next(ui + 1, nxt);
        const char* nA = has_next ? (const char*)g.A + (size_t)nxt.pm * tstep : cA; const char* nB = has_next ? (const char*)g.Bt + (size_t)nxt.pn * tstep : cB;
        for (int t = 0; t < nt; t += 2) {
            const bool last = (t == nt - 2);
            const char* a1 = cA + (size_t)(t + 1) * kstep;
            const char* a2 = last ? nA : cA + (size_t)(t + 2) * kstep; const char* b2 = last ? nB : cB + (size_t)(t + 2) * kstep;
            const char* a3 = a2 + kstep; const char* b3 = b2 + kstep;
            if (last && has_next) S.a_ready(nxt);
            if constexpr (SP2) {
            PG8_LDB(B0, 0, 0); PG8_LDB(B1, 0, 1); PG8_SCHED; PG8_LDA(At, 0, 0); PG8_STAGE(PG8_SA(1, 1), a1 + hstep, voffA);
            PG8_WAIT_V(8); PG8_WAIT_L(0); PG8_BAR; PG8_MMA(0, 0, At, B0); PG8_MMA(0, 1, At, B1); PG8_BAR; PG8_SCHED;
            PG8_LDA(At, 0, 1); PG8_STAGE(PG8_SB(0, 0), b2, voffB); PG8_STAGE(PG8_SB(0, 1), b2 + hstep, voffB); PG8_STAGE(PG8_SA(0, 0), a2, voffA);
            PG8_WAIT_V(8); PG8_WAIT_L(0); PG8_BAR; PG8_MMA(1, 0, At, B0); PG8_MMA(1, 1, At, B1); PG8_BAR; PG8_SCHED;
            PG8_LDB(B0, 1, 0); PG8_LDB(B1, 1, 1); PG8_SCHED; PG8_LDA(At, 1, 0); PG8_STAGE(PG8_SA(0, 1), a2 + hstep, voffA);
            PG8_WAIT_V(8); PG8_WAIT_L(0); PG8_BAR; PG8_MMA(0, 0, At, B0); PG8_MMA(0, 1, At, B1); PG8_BAR; PG8_SCHED;
            PG8_LDA(At, 1, 1); PG8_STAGE(PG8_SB(1, 0), b3, voffB); PG8_STAGE(PG8_SB(1, 1), b3 + hstep, voffB); PG8_STAGE(PG8_SA(1, 0), a3, voffA);
            PG8_WAIT_V(8); PG8_WAIT_L(0); PG8_BAR; PG8_MMA(1, 0, At, B0); PG8_MMA(1, 1, At, B1); PG8_BAR; PG8_SCHED;
            } else {
            PG8_LDB(B0, 0, 0); PG8_SCHED; PG8_LDA(At, 0, 0); PG8_STAGE(PG8_SA(1, 1), a1 + hstep, voffA);
            PG8_WAIT_L(8); PG8_BAR; PG8_WAIT_L(0); PG8_MMA(0, 0, At, B0); PG8_BAR; PG8_SCHED;
            PG8_LDB(B1, 0, 1); PG8_STAGE(PG8_SB(0, 0), b2, voffB);
            PG8_BAR; PG8_WAIT_L(0); PG8_MMA(0, 1, At, B1); PG8_BAR;
            PG8_LDA(At, 0, 1); PG8_STAGE(PG8_SA(0, 0), a2, voffA);
            PG8_BAR; PG8_WAIT_L(0); PG8_MMA(1, 0, At, B0); PG8_BAR; PG8_SCHED;
            PG8_STAGE(PG8_SB(0, 1), b2 + hstep, voffB);
            PG8_WAIT_V(6); PG8_BAR; PG8_MMA(1, 1, At, B1); PG8_BAR;
            PG8_LDB(B0, 1, 0); PG8_SCHED; PG8_LDA(At, 1, 0); PG8_STAGE(PG8_SA(0, 1), a2 + hstep, voffA);
            PG8_WAIT_L(8); PG8_BAR; PG8_WAIT_L(0); PG8_MMA(0, 0, At, B0); PG8_BAR; PG8_SCHED;
            PG8_LDB(B1, 1, 1); PG8_STAGE(PG8_SB(1, 0), b3, voffB);
            PG8_BAR; PG8_WAIT_L(0); PG8_MMA(0, 1, At, B1); PG8_BAR;
            PG8_LDA(At, 1, 1); PG8_STAGE(PG8_SA(1, 0), a3, voffA);
            PG8_BAR; PG8_WAIT_L(0); PG8_MMA(1, 0, At, B0); PG8_BAR; PG8_SCHED;
            PG8_STAGE(PG8_SB(1, 1), b3 + hstep, voffB);
            PG8_WAIT_V(6); PG8_BAR; PG8_MMA(1, 1, At, B1); PG8_BAR;
            }
        }
        if constexpr (ALIGN_EPI) { if (wr == 0) PG8_BAR; }
        if constexpr (!Epi::AFTER_DRAIN) { E(acc, cur, wr, wc, fr, fq); S.done(cur); }
        if (!has_next) break;
#pragma unroll
        for (int a = 0; a < 2; ++a)
#pragma unroll
            for (int b = 0; b < 2; ++b)
#pragma unroll
                for (int m = 0; m < 4; ++m)
#pragma unroll
                    for (int n = 0; n < 2; ++n) acc[a][b][m][n] = (f32x4){0.f, 0.f, 0.f, 0.f};
        cur = nxt; cA = nA; cB = nB; ++ui;
        if constexpr (ALIGN_EPI) { if (wr == 1) PG8_BAR; }
    }
    PG8_WAIT_V(0);
    if constexpr (!ALIGN_EPI) { if (wr == 0) PG8_BAR; }
    PG8_BAR;
    if constexpr (Epi::AFTER_DRAIN) { E.fused(acc, cur, wr, wc, fr, fq, lds, wid, lane); S.done(cur); }
#undef PG8_SA
#undef PG8_SB
#undef PG8_STAGE
#undef PG8_LDA
#undef PG8_LDB
#undef PG8_MMA
#undef PG8_WAIT_V
#undef PG8_WAIT_L
#undef PG8_BAR
#undef PG8_SCHED
}
}
#define GAS __attribute__((address_space(1)))
#define LAS __attribute__((address_space(3)))
typedef unsigned short bf16;
typedef unsigned v4u __attribute__((ext_vector_type(4)));
typedef float f32x4 __attribute__((ext_vector_type(4)));
typedef short bf16x8 __attribute__((ext_vector_type(8)));
typedef GAS unsigned gu32;
typedef GAS unsigned long long gu64;
#define RLX_AGENT __ATOMIC_RELAXED, __HIP_MEMORY_SCOPE_AGENT
#define LDS_WAIT() asm volatile("s_waitcnt lgkmcnt(0)" ::: "memory")
#define VM_WAIT() asm volatile("s_waitcnt vmcnt(0)" ::: "memory")
__device__ __forceinline__ unsigned long long rt() { return __builtin_amdgcn_s_memrealtime(); }
__device__ __forceinline__ unsigned f2bf(float f) { unsigned u = __builtin_bit_cast(unsigned, f); return (u + 0x7fffu + ((u >> 16) & 1u)) >> 16; }
__device__ __forceinline__ unsigned pk2(float lo, float hi) { return f2bf(lo) | (f2bf(hi) << 16); }

#define XB_TMO      128
#define XB_XCNT(j)  (256  + 64 * (j))
#define XB_XSUB(j)  (1280 + 64 * (j))
#define XB_XGEN(j)  (2304 + 64 * (j))
#define XB_TOP      3328
#define XB_TOPGEN   3392
#define XCD_BAR_WORDS 3456
#define XB_SPIN_CAP (1u << 18)

__device__ __forceinline__ unsigned xb_ld(unsigned* p)              { return __hip_atomic_load(p, __ATOMIC_RELAXED, __HIP_MEMORY_SCOPE_AGENT); }
__device__ __forceinline__ unsigned xb_add(unsigned* p, unsigned v) { return __hip_atomic_fetch_add(p, v, __ATOMIC_RELAXED, __HIP_MEMORY_SCOPE_AGENT); }
__device__ __forceinline__ unsigned xb_xcc_id() { return (unsigned)__builtin_amdgcn_s_getreg((3 << 11) | 20) & 0xFu; }
#define XB_SPIN(cond, bar) do { unsigned _sp = 0; while (cond) { __builtin_amdgcn_s_sleep(1); \
    if ((++_sp & 255u) == 0u) { if (xb_ld(&(bar)[XB_TMO])) break; if (_sp > XB_SPIN_CAP) { atomicAdd(&(bar)[XB_TMO], 1u); break; } } } } while (0)

struct XcdBarrier {
    unsigned* bar; unsigned x;
    volatile LAS unsigned* st;
};

__device__ __forceinline__ XcdBarrier xcd_barrier_post(unsigned* bar, volatile LAS unsigned* st) {
    XcdBarrier b; b.bar = bar; b.x = xb_xcc_id(); b.st = st;
    if (threadIdx.x == 0) (void)xb_add(&bar[XB_XCNT(b.x)], 1u);
    return b;
}
__device__ __forceinline__ void xcd_barrier_complete(unsigned* bar, unsigned x, unsigned& nloc, unsigned& nx) {
    const unsigned G = gridDim.x * gridDim.y * gridDim.z;
    unsigned sum, cnt, mine, sp = 0u;
    for (;;) {
        sum = 0u; cnt = 0u; mine = 0u;
#pragma unroll
        for (unsigned j = 0; j < 16; ++j) { const unsigned c = xb_ld(&bar[XB_XCNT(j)]); sum += c; cnt += (c > 0u) ? 1u : 0u; mine = (j == x) ? c : mine; }
        if (sum == G) break;
        __builtin_amdgcn_s_sleep(1);
        if ((++sp & 255u) == 0u) { if (xb_ld(&bar[XB_TMO])) break; if (sp > XB_SPIN_CAP) { atomicAdd(&bar[XB_TMO], 1u); break; } }
    }
    nloc = mine > 0u ? mine : 1u; nx = cnt > 0u ? cnt : 1u;
}

__device__ __forceinline__ void xcd_barrier(const XcdBarrier& b) {
    asm volatile("s_waitcnt vmcnt(0)" ::: "memory");
    __syncthreads();
    if (threadIdx.x == 0) {
        unsigned* bar = b.bar;
        __builtin_amdgcn_s_waitcnt(0);
        unsigned nloc = b.st[0], nx = b.st[1];
        if (nloc == 0u) { xcd_barrier_complete(bar, b.x, nloc, nx); b.st[0] = nloc; b.st[1] = nx; }
        const unsigned old = xb_add(&bar[XB_XSUB(b.x)], 1u);
        const unsigned gen = old / nloc;
        if (old + 1u == (gen + 1u) * nloc) {
            __builtin_amdgcn_fence(__ATOMIC_RELEASE, "agent");
            asm volatile("s_waitcnt vmcnt(0)" ::: "memory");
            const unsigned og = xb_add(&bar[XB_TOP], 1u);
            const unsigned tg = og / nx;
            if (og + 1u == (tg + 1u) * nx) xb_add(&bar[XB_TOPGEN], 1u);
            else XB_SPIN(xb_ld(&bar[XB_TOPGEN]) == tg, bar);
            __builtin_amdgcn_fence(__ATOMIC_ACQUIRE, "agent");
            xb_add(&bar[XB_XGEN(b.x)], 1u);
            asm volatile("s_waitcnt vmcnt(0)" ::: "memory");
        } else {
            XB_SPIN(xb_ld(&bar[XB_XGEN(b.x)]) == gen, bar);
            __builtin_amdgcn_fence(__ATOMIC_ACQUIRE, "agent");
            asm volatile("s_waitcnt vmcnt(0)" ::: "memory");
        }
    }
    __syncthreads();
}

constexpr int D = 2048, SEQ = 16384, NB = 2, CTXL = 256, FF = 5632;
constexpr int MLAT = NB * SEQ;
constexpr int MCTX = NB * CTXL;
constexpr int MALL = MLAT + MCTX;
constexpr int NMOD = 9 * D;
constexpr int KVD = 512;
constexpr float EPSN = 1e-6f;
constexpr int NWAVES = 8;

constexpr size_t MiB = 1u << 20;
constexpr size_t WS_CTL = 0, CTL_ZERO_BYTES = 2 * MiB;
constexpr size_t WS_MODS = 1 * MiB;
constexpr size_t WS_ROPE = 2 * MiB;
constexpr size_t WS_XCTX = 10 * MiB;
constexpr size_t WS_WIN = 16 * MiB, WIN_STRIDE = 44 * MiB;
constexpr size_t WS_WOUT = 192 * MiB, WOUT_STRIDE = 22 * MiB;
constexpr size_t WS_WQKV = 280 * MiB, WS_WO = 292 * MiB, WS_WSIN = 300 * MiB, WS_WGLU = 308 * MiB;
constexpr size_t WS_H = 324 * MiB;
constexpr size_t WS_OUT = 454 * MiB;
constexpr size_t WS_ACT = 584 * MiB;
constexpr size_t WS_Q = 942 * MiB, WS_K = 1072 * MiB, WS_V = 1105 * MiB;
constexpr size_t WS_U = 1138 * MiB;
constexpr size_t WS_Y = 584 * MiB;
constexpr size_t WS_END = 1268 * MiB;
constexpr int CW_BAR = 4096;

constexpr int LDS_BYTES = 147456;
constexpr int MISC_OFF = 131072 + 320;

__device__ __forceinline__ float wave_sum(float v) {
#pragma unroll
    for (int o = 1; o < 64; o <<= 1) v += __shfl_xor(v, o);
    return v;
}
__device__ __forceinline__ float wave_max(float v) {
#pragma unroll
    for (int o = 1; o < 64; o <<= 1) v = fmaxf(v, __shfl_xor(v, o));
    return v;
}
__device__ __forceinline__ float bflo(unsigned w) { return __uint_as_float(w << 16); }
__device__ __forceinline__ float bfhi(unsigned w) { return __uint_as_float(w & 0xffff0000u); }

namespace pg8 {
struct EpiPlain {
    static constexpr bool PERM = true, AFTER_DRAIN = false;
    bf16_t* O; int ldc;
    __device__ __forceinline__ void operator()(const f32x4 (&acc)[2][2][4][2], const Unit& u, int wr, int wc, int fr, int fq) const {
        const int row0 = u.pm * BM + wr * 64 + fr, col0 = u.pn * BM + wc * 32 + 8 * fq;
#pragma unroll
        for (int ai = 0; ai < 2; ++ai)
#pragma unroll
            for (int m = 0; m < 4; ++m) { bf16_t* rowp = O + (size_t)(row0 + ai * HALF + m * 16) * ldc + col0;
#pragma unroll
                for (int bj = 0; bj < 2; ++bj) { const f32x4 v0 = acc[ai][bj][m][0], v1 = acc[ai][bj][m][1];
                    u32x4 w; w.x = cvt_pk_bf16(v0[0], v0[1]); w.y = cvt_pk_bf16(v0[2], v0[3]); w.z = cvt_pk_bf16(v1[0], v1[1]); w.w = cvt_pk_bf16(v1[2], v1[3]);
                    *(u32x4*)(rowp + bj * HALF) = w; } }
    }
};
template <int MODE> struct EpiGated {
    static constexpr bool PERM = true, AFTER_DRAIN = false;
    bf16_t* O; int ldc;
    __device__ __forceinline__ void operator()(const f32x4 (&acc)[2][2][4][2], const Unit& u, int wr, int wc, int fr, int fq) const {
        typedef unsigned u32x2 __attribute__((ext_vector_type(2)));
        const int row0 = u.pm * BM + wr * 64 + fr, col0 = u.pn * (BM / 2) + wc * 16 + 4 * fq;
#pragma unroll
        for (int ai = 0; ai < 2; ++ai)
#pragma unroll
            for (int m = 0; m < 4; ++m) { bf16_t* rowp = O + (size_t)(row0 + ai * HALF + m * 16) * ldc + col0;
#pragma unroll
                for (int bj = 0; bj < 2; ++bj) { const f32x4 v0 = acc[ai][bj][m][0], v1 = acc[ai][bj][m][1]; float r[4];
#pragma unroll
                    for (int e = 0; e < 4; ++e) {
                        if (MODE == 0) r[e] = v0[e] * __builtin_amdgcn_rcpf(1.0f + __expf(-v0[e])) * v1[e];
                        else           r[e] = v0[e] * __builtin_amdgcn_rcpf(1.0f + __expf(-v1[e])); }
                    u32x2 w; w.x = cvt_pk_bf16(r[0], r[1]); w.y = cvt_pk_bf16(r[2], r[3]);
                    *(u32x2*)(rowp + bj * (HALF / 2)) = w; } }
    }
};
struct EpiQKV {
    static constexpr bool PERM = true, AFTER_DRAIN = false;
    bf16_t* Q; bf16_t* K; bf16_t* V; const float* rope; float qscale;
    __device__ __forceinline__ void operator()(const f32x4 (&acc)[2][2][4][2], const Unit& u, int wr, int wc, int fr, int fq) const {
        const int row0 = u.pm * BM + wr * 64 + fr; const int pn = u.pn;
        if (pn >= 10) {
            const int col0 = (pn - 10) * BM + wc * 32 + 8 * fq;
#pragma unroll
            for (int ai = 0; ai < 2; ++ai)
#pragma unroll
                for (int m = 0; m < 4; ++m) { bf16_t* rowp = V + (size_t)(row0 + ai * HALF + m * 16) * KVD + col0;
#pragma unroll
                    for (int bj = 0; bj < 2; ++bj) { const f32x4 v0 = acc[ai][bj][m][0], v1 = acc[ai][bj][m][1];
                        u32x4 w; w.x = cvt_pk_bf16(v0[0], v0[1]); w.y = cvt_pk_bf16(v0[2], v0[3]); w.z = cvt_pk_bf16(v1[0], v1[1]); w.w = cvt_pk_bf16(v1[2], v1[3]);
                        *(u32x4*)(rowp + bj * HALF) = w; } }
            return;
        }
        const bool isq = pn < 8; const bool lat = u.pm < (MLAT / BM);
        const float sc = isq ? qscale : 1.0f;
        const int tcol = (wc >> 1) * 32 + 16 * (wc & 1) + 4 * fq;
#pragma unroll
        for (int ai = 0; ai < 2; ++ai)
#pragma unroll
            for (int m = 0; m < 4; ++m) {
                const int row = row0 + ai * HALF + m * 16;
                f32x4 t0 = (f32x4){1.f, 0.f, 1.f, 0.f}, t1 = (f32x4){1.f, 0.f, 1.f, 0.f};
                if (lat) { const f32x4* tp = (const f32x4*)(rope + ((size_t)(row & (SEQ - 1)) * 64 + tcol) * 2); t0 = tp[0]; t1 = tp[1]; }
#pragma unroll
                for (int bj = 0; bj < 2; ++bj) { const f32x4 v0 = acc[ai][bj][m][0], v1 = acc[ai][bj][m][1];
                    const float a0 = (v0[0] * t0[0] - v0[1] * t0[1]) * sc, a1 = (v0[1] * t0[0] + v0[0] * t0[1]) * sc;
                    const float a2 = (v0[2] * t0[2] - v0[3] * t0[3]) * sc, a3 = (v0[3] * t0[2] + v0[2] * t0[3]) * sc;
                    const float b0 = (v1[0] * t1[0] - v1[1] * t1[1]) * sc, b1 = (v1[1] * t1[0] + v1[0] * t1[1]) * sc;
                    const float b2 = (v1[2] * t1[2] - v1[3] * t1[3]) * sc, b3 = (v1[3] * t1[2] + v1[2] * t1[3]) * sc;
                    u32x4 w; w.x = cvt_pk_bf16(a0, a1); w.y = cvt_pk_bf16(a2, a3); w.z = cvt_pk_bf16(b0, b1); w.w = cvt_pk_bf16(b2, b3);
                    bf16_t* dst = isq ? Q + (size_t)row * D + (pn * 2 + bj) * 128 + wc * 32 + 8 * fq
                                      : K + (size_t)row * KVD + ((pn - 8) * 2 + bj) * 128 + wc * 32 + 8 * fq;
                    *(u32x4*)dst = w; } }
    }
};
}

struct Args { const float* in[22]; float* out; unsigned char* ws; int ph_lo, ph_hi; };
struct Ctx {
    LAS unsigned char* lds;
    int tid, lane, wave, G, gw, NGW;
    const float* const* in;
    float* out; unsigned char* ws;
};

__device__ __forceinline__ int map_row(int mode, int n, int N) {
    if (mode == 1) { const int half = N >> 1; const int hi = n >= half ? 1 : 0; const int j = n - hi * half; return ((j >> 2) << 3) + hi * 4 + (j & 3); }
    if (mode == 2) { if (n >= 2560) return n; const int head = n >> 7, d = n & 127, a = d >> 6, dd = d & 63, which = dd >> 5, i = dd & 31; return (head << 7) + (a << 6) + 2 * i + which; }
    return n;
}
__device__ __forceinline__ void transpose_item(const float* W, int K, int N, bf16* WT, int mode, LAS float* scr, int item, int lane) {
    const int nblk = N / 32, kb = item / nblk, nb = item % nblk, k0 = 64 * kb, n0 = 32 * nb;
    float v[32];
#pragma unroll
    for (int i = 0; i < 32; ++i) v[i] = W[(size_t)(k0 + 2 * i + (lane >> 5)) * N + n0 + (lane & 31)];
#pragma unroll
    for (int i = 0; i < 32; ++i) scr[(2 * i + (lane >> 5)) * 33 + (lane & 31)] = v[i];
    LDS_WAIT(); asm volatile("" ::: "memory");
    const int c = lane & 7;
#pragma unroll
    for (int j = 0; j < 4; ++j) { const int n = (lane >> 3) + 8 * j; const LAS float* s = scr + (8 * c) * 33 + n;
        v4u o; o.x = pk2(s[0 * 33], s[1 * 33]); o.y = pk2(s[2 * 33], s[3 * 33]); o.z = pk2(s[4 * 33], s[5 * 33]); o.w = pk2(s[6 * 33], s[7 * 33]);
        *(v4u*)(WT + (size_t)map_row(mode, n0 + n, N) * K + k0 + 8 * c) = o; }
    LDS_WAIT(); asm volatile("" ::: "memory");
}
__device__ __forceinline__ float siluf(float x) { return x / (1.0f + __expf(-x)); }

__device__ __forceinline__ void p0_prologue(const Ctx& C) {
    LAS float* scr = (LAS float*)(C.lds + C.wave * 16384);
    const int lane = C.lane;
    constexpr int I_WIN = (D / 64) * (2 * FF / 32), I_WOUT = (FF / 64) * (D / 32), I_QKV = (D / 64) * (3072 / 32), I_SQ = (D / 64) * (D / 32), I_GLU = (D / 64) * (4096 / 32);
    constexpr int NITEMS = 4 * I_WIN + 4 * I_WOUT + I_QKV + 2 * I_SQ + I_GLU;
    for (int it = C.gw; it < NITEMS; it += C.NGW) {
        int r = it; const float* W; int K, N, mode; bf16* WT;
        if (r < 4 * I_WIN) { const int w = r / I_WIN; r -= w * I_WIN; W = C.in[7] + (size_t)w * D * 2 * FF; K = D; N = 2 * FF; mode = 1; WT = (bf16*)(C.ws + WS_WIN + w * WIN_STRIDE); }
        else { r -= 4 * I_WIN;
            if (r < 4 * I_WOUT) { const int w = r / I_WOUT; r -= w * I_WOUT; W = C.in[8] + (size_t)w * FF * D; K = FF; N = D; mode = 0; WT = (bf16*)(C.ws + WS_WOUT + w * WOUT_STRIDE); }
            else { r -= 4 * I_WOUT;
                if (r < I_QKV) { W = C.in[9]; K = D; N = 3072; mode = 2; WT = (bf16*)(C.ws + WS_WQKV); }
                else { r -= I_QKV;
                    if (r < I_SQ) { W = C.in[10]; K = D; N = D; mode = 0; WT = (bf16*)(C.ws + WS_WO); }
                    else { r -= I_SQ;
                        if (r < I_SQ) { W = C.in[12]; K = D; N = D; mode = 0; WT = (bf16*)(C.ws + WS_WSIN); }
                        else { r -= I_SQ; W = C.in[21]; K = D; N = 4096; mode = 1; WT = (bf16*)(C.ws + WS_WGLU); } } } } }
        transpose_item(W, K, N, WT, mode, scr, r, lane);
    }
    {
        float* mods = (float*)(C.ws + WS_MODS);
        const float* cvec = C.in[1]; const float* cctx = C.in[3]; const float* adaw = C.in[4]; const float* adab = C.in[5];
        for (int it = C.gw; it < 2 * 72 * 16; it += C.NGW) {
            const int l = it / 1152, r = it % 1152, jb = r / 16, ks = r % 16, j0 = jb * 256 + lane * 4, k0 = ks * 128;
            const float sa0 = siluf(cvec[k0 + lane]), sb0 = siluf(cvec[k0 + 64 + lane]);
            const float sa1 = siluf(cvec[D + k0 + lane]), sb1 = siluf(cvec[D + k0 + 64 + lane]);
            const float sa2 = siluf(cctx[k0 + lane]), sb2 = siluf(cctx[k0 + 64 + lane]);
            f32x4 a0 = (f32x4){0.f, 0.f, 0.f, 0.f}, a1 = a0, a2 = a0;
            const float* wp = adaw + ((size_t)l * D + k0) * NMOD + j0;
#pragma unroll 16
            for (int kk = 0; kk < 64; ++kk) { const f32x4 w = *(const f32x4*)(wp + (size_t)kk * NMOD);
                const float s0 = __shfl(sa0, kk), s1 = __shfl(sa1, kk), s2 = __shfl(sa2, kk);
                a0 += w * s0; a1 += w * s1; a2 += w * s2; }
#pragma unroll 16
            for (int kk = 0; kk < 64; ++kk) { const f32x4 w = *(const f32x4*)(wp + (size_t)(64 + kk) * NMOD);
                const float s0 = __shfl(sb0, kk), s1 = __shfl(sb1, kk), s2 = __shfl(sb2, kk);
                a0 += w * s0; a1 += w * s1; a2 += w * s2; }
            if (ks == 0) { const f32x4 bb = *(const f32x4*)(adab + (size_t)l * NMOD + j0); a0 += bb; a1 += bb; a2 += bb; }
            float* m0 = mods + ((size_t)(l * 3 + 0)) * NMOD + j0; float* m1 = m0 + NMOD; float* m2 = m1 + NMOD;
#pragma unroll
            for (int e = 0; e < 4; ++e) {
                __hip_atomic_fetch_add(m0 + e, a0[e], __ATOMIC_RELAXED, __HIP_MEMORY_SCOPE_AGENT);
                __hip_atomic_fetch_add(m1 + e, a1[e], __ATOMIC_RELAXED, __HIP_MEMORY_SCOPE_AGENT);
                __hip_atomic_fetch_add(m2 + e, a2[e], __ATOMIC_RELAXED, __HIP_MEMORY_SCOPE_AGENT); }
        }
    }
    {
        float* rope = (float*)(C.ws + WS_ROPE);
        for (int idx = C.gw * 64 + lane; idx < SEQ * 64; idx += C.NGW * 64) {
            const int t = idx >> 6, a = (idx >> 5) & 1, i = idx & 31;
            const float pos = (float)(a ? (t & 63) : (t >> 6));
            const float invf = powf(10000.0f, -(float)(2 * i) / 64.0f);
            const float ang = pos * invf; float sn, cs; sincosf(ang, &sn, &cs);
            *(float2*)(rope + (size_t)idx * 2) = make_float2(cs, sn);
        }
    }
}

__device__ __forceinline__ void thin_phase(const Ctx& C, bool has_post, int lpost, int gpost, int igate, float wgt,
                                           bool has_pre, int lpre, int gpre, int ishift, int iscale,
                                           const float* xs_lat, const float* xs_ctx, float* xd_lat, float* xd_ctx, int nrows) {
    LAS float* vec = (LAS float*)C.lds;
    const float* mods = (const float*)(C.ws + WS_MODS); const float* ng = C.in[6];
    for (int i = C.tid; i < 3 * D; i += NWAVES * 64) {
        const int v = i / D, col = i % D; float A = 0.f, B = 0.f, Cc = 0.f;
        if (has_post) A = wgt * mods[(size_t)(lpost * 3 + v) * NMOD + igate * D + col] * ng[(lpost * 6 + gpost) * D + col];
        if (has_pre) { B = ng[(lpre * 6 + gpre) * D + col] * (1.0f + mods[(size_t)(lpre * 3 + v) * NMOD + iscale * D + col]); Cc = mods[(size_t)(lpre * 3 + v) * NMOD + ishift * D + col]; }
        vec[(v * 3 + 0) * D + col] = A; vec[(v * 3 + 1) * D + col] = B; vec[(v * 3 + 2) * D + col] = Cc;
    }
    __syncthreads();
    const bf16* OUTB = (const bf16*)(C.ws + WS_OUT); bf16* HB = (bf16*)(C.ws + WS_H);
    const int lane = C.lane;
    for (int row = C.gw; row < nrows; row += C.NGW) {
        const bool lat = row < MLAT; const int v = lat ? (row >> 14) : 2;
        const float* xs = lat ? xs_lat + (size_t)row * D : xs_ctx + (size_t)(row - MLAT) * D;
        const LAS f32x4* vA = (const LAS f32x4*)(vec + (v * 3 + 0) * D) + lane;
        const LAS f32x4* vB = (const LAS f32x4*)(vec + (v * 3 + 1) * D) + lane;
        const LAS f32x4* vC = (const LAS f32x4*)(vec + (v * 3 + 2) * D) + lane;
        f32x4 x[8];
#pragma unroll
        for (int j = 0; j < 8; ++j) x[j] = ((const f32x4*)xs)[lane + 64 * j];
        if (has_post) {
            const uint2* op = (const uint2*)(OUTB + (size_t)row * D) + lane; f32x4 o[8]; float ss = 0.f;
#pragma unroll
            for (int j = 0; j < 8; ++j) { const uint2 w = op[64 * j]; o[j] = (f32x4){bflo(w.x), bfhi(w.x), bflo(w.y), bfhi(w.y)}; ss += (o[j][0] * o[j][0] + o[j][1] * o[j][1]) + (o[j][2] * o[j][2] + o[j][3] * o[j][3]); }
            const float rstd = rsqrtf(wave_sum(ss) * (1.0f / D) + EPSN);
#pragma unroll
            for (int j = 0; j < 8; ++j) x[j] += vA[64 * j] * (o[j] * rstd);
        }
        if (xd_lat) { float* xd = lat ? xd_lat + (size_t)row * D : xd_ctx + (size_t)(row - MLAT) * D;
#pragma unroll
            for (int j = 0; j < 8; ++j) ((f32x4*)xd)[lane + 64 * j] = x[j]; }
        if (has_pre) {
            float ss = 0.f;
#pragma unroll
            for (int j = 0; j < 8; ++j) ss += (x[j][0] * x[j][0] + x[j][1] * x[j][1]) + (x[j][2] * x[j][2] + x[j][3] * x[j][3]);
            const float rstd = rsqrtf(wave_sum(ss) * (1.0f / D) + EPSN);
            uint2* hp = (uint2*)(HB + (size_t)row * D) + lane;
#pragma unroll
            for (int j = 0; j < 8; ++j) { const f32x4 h = (x[j] * rstd) * vB[64 * j] + vC[64 * j]; uint2 w; w.x = pk2(h[0], h[1]); w.y = pk2(h[2], h[3]); hp[64 * j] = w; }
        }
    }
    __syncthreads();
}

__device__ __forceinline__ void attn_simple(const Ctx& C, const bf16* Q, const bf16* Kb, const bf16* Vb, const float* sink, bf16* O, int nrows) {
    LAS float* qs = (LAS float*)(C.lds + C.wave * 2048);
    const int lane = C.lane;
    for (int it = C.gw; it < nrows * 4; it += C.NGW) {
        const int row = it >> 2, hk = it & 3;
        { const uint4 raw = *(const uint4*)(Q + (size_t)row * D + hk * 512 + lane * 8);
          LAS f32x4* q4 = (LAS f32x4*)(qs + lane * 8);
          q4[0] = (f32x4){bflo(raw.x), bfhi(raw.x), bflo(raw.y), bfhi(raw.y)}; q4[1] = (f32x4){bflo(raw.z), bfhi(raw.z), bflo(raw.w), bfhi(raw.w)}; }
        LDS_WAIT(); asm volatile("" ::: "memory");
        int b, nband, lo;
        if (row < MLAT) { b = row >> 14; const int t = row & (SEQ - 1); lo = t - 128 < 0 ? 0 : t - 128; const int hi = t + 128 > SEQ - 1 ? SEQ - 1 : t + 128; nband = hi - lo + 1; }
        else { b = (row - MLAT) >> 8; nband = 0; lo = 0; }
        const size_t band_row0 = (size_t)b * SEQ + lo, ctx_row0 = (size_t)MLAT + b * CTXL;
        float s[9][4];
#pragma unroll
        for (int c = 0; c < 9; ++c) {
            bool valid; size_t krow; bool active;
            if (c < 5) { const int kidx = c * 64 + lane; valid = kidx < nband; krow = band_row0 + (valid ? kidx : 0); active = c * 64 < nband; }
            else { valid = true; krow = ctx_row0 + (c - 5) * 64 + lane; active = true; }
            float d0 = 0.f, d1 = 0.f, d2 = 0.f, d3 = 0.f;
            if (active) {
                const uint4* kp = (const uint4*)(Kb + krow * KVD + hk * 128);
                const LAS f32x4* q4 = (const LAS f32x4*)qs;
#pragma unroll 4
                for (int i = 0; i < 16; ++i) { const uint4 kw = kp[i];
                    const f32x4 ka = (f32x4){bflo(kw.x), bfhi(kw.x), bflo(kw.y), bfhi(kw.y)}, kb2 = (f32x4){bflo(kw.z), bfhi(kw.z), bflo(kw.w), bfhi(kw.w)};
                    { const f32x4 qa = q4[0 * 32 + 2 * i], qb = q4[0 * 32 + 2 * i + 1]; d0 += (ka[0] * qa[0] + ka[1] * qa[1]) + (ka[2] * qa[2] + ka[3] * qa[3]) + (kb2[0] * qb[0] + kb2[1] * qb[1]) + (kb2[2] * qb[2] + kb2[3] * qb[3]); }
                    { const f32x4 qa = q4[1 * 32 + 2 * i], qb = q4[1 * 32 + 2 * i + 1]; d1 += (ka[0] * qa[0] + ka[1] * qa[1]) + (ka[2] * qa[2] + ka[3] * qa[3]) + (kb2[0] * qb[0] + kb2[1] * qb[1]) + (kb2[2] * qb[2] + kb2[3] * qb[3]); }
                    { const f32x4 qa = q4[2 * 32 + 2 * i], qb = q4[2 * 32 + 2 * i + 1]; d2 += (ka[0] * qa[0] + ka[1] * qa[1]) + (ka[2] * qa[2] + ka[3] * qa[3]) + (kb2[0] * qb[0] + kb2[1] * qb[1]) + (kb2[2] * qb[2] + kb2[3] * qb[3]); }
                    { const f32x4 qa = q4[3 * 32 + 2 * i], qb = q4[3 * 32 + 2 * i + 1]; d3 += (ka[0] * qa[0] + ka[1] * qa[1]) + (ka[2] * qa[2] + ka[3] * qa[3]) + (kb2[0] * qb[0] + kb2[1] * qb[1]) + (kb2[2] * qb[2] + kb2[3] * qb[3]); }
                }
            }
            s[c][0] = valid ? d0 : -1e30f; s[c][1] = valid ? d1 : -1e30f; s[c][2] = valid ? d2 : -1e30f; s[c][3] = valid ? d3 : -1e30f;
        }
        float inv[4];
#pragma unroll
        for (int g = 0; g < 4; ++g) {
            const float sk = sink[hk * 4 + g]; float m = sk;
#pragma unroll
            for (int c = 0; c < 9; ++c) m = fmaxf(m, s[c][g]);
            m = wave_max(m); float sum = 0.f;
#pragma unroll
            for (int c = 0; c < 9; ++c) { const float p = __expf(s[c][g] - m); s[c][g] = p; sum += p; }
            sum = wave_sum(sum) + __expf(sk - m); inv[g] = 1.0f / sum;
        }
        float o[4][2];
#pragma unroll
        for (int g = 0; g < 4; ++g) { o[g][0] = 0.f; o[g][1] = 0.f; }
#pragma unroll
        for (int c = 0; c < 9; ++c) {
            int cnt; size_t r0;
            if (c < 5) { cnt = nband - c * 64; cnt = cnt < 0 ? 0 : (cnt > 64 ? 64 : cnt); r0 = band_row0 + c * 64; } else { cnt = 64; r0 = ctx_row0 + (c - 5) * 64; }
            cnt = __builtin_amdgcn_readfirstlane(cnt);
            const bf16* vp = Vb + r0 * KVD + hk * 128 + 2 * lane;
            for (int j = 0; j < cnt; ++j) {
                const unsigned vv = *(const unsigned*)(vp + (size_t)j * KVD); const float v0 = bflo(vv), v1 = bfhi(vv);
#pragma unroll
                for (int g = 0; g < 4; ++g) { const float pg = __int_as_float(__builtin_amdgcn_readlane(__float_as_int(s[c][g]), j)); o[g][0] += pg * v0; o[g][1] += pg * v1; }
            }
        }
#pragma unroll
        for (int g = 0; g < 4; ++g) *(unsigned*)(O + (size_t)row * D + (hk * 4 + g) * 128 + 2 * lane) = pk2(o[g][0] * inv[g], o[g][1] * inv[g]);
    }
}

__device__ __forceinline__ int scan_row(int dir, int b, int i) {
    if (i < CTXL) return MLAT + b * CTXL + (dir ? CTXL - 1 - i : i);
    const int j = i - CTXL; return b * SEQ + (dir ? SEQ - 1 - j : j);
}
__device__ __forceinline__ void scan_simple(const Ctx& C, const bf16* U, float* Y) {
    const int lane = C.lane;
    const float* a_re = C.in[13]; const float* a_im = C.in[14]; const float* log_dt = C.in[15];
    const float* b_re = C.in[16]; const float* b_im = C.in[17]; const float* c_re = C.in[18]; const float* c_im = C.in[19];
    for (int unit = (int)blockIdx.x + C.G * C.wave; unit < 512; unit += C.G * NWAVES) {
        const int dir = unit >> 8, b = (unit >> 7) & 1, g = unit & 127, dg = dir * 128 + g;
        const int idx = dg * 64 + lane;
        const float are = a_re[idx], aim = a_im[idx], dt = expf(log_dt[dg]);
        const float mag = expf(are * dt), abr = mag * cosf(aim * dt), abi = mag * sinf(aim * dt);
        const float den = are * are + aim * aim, xr = abr - 1.0f, xi = abi;
        const float fr = (xr * are + xi * aim) / den, fi = (xi * are - xr * aim) / den;
        float Bre[16], Bim[16], Cre[16], Cim[16];
#pragma unroll
        for (int c = 0; c < 16; ++c) { const float br = b_re[(size_t)idx * 16 + c], bi = b_im[(size_t)idx * 16 + c]; Bre[c] = fr * br - fi * bi; Bim[c] = fr * bi + fi * br;
            Cre[c] = c_re[((size_t)dg * 16 + c) * 64 + lane]; Cim[c] = c_im[((size_t)dg * 16 + c) * 64 + lane]; }
        float hr = 0.f, hi = 0.f;
        float* Yd = Y + (size_t)dir * MALL * D;
        uint4 cur[4][2], nxt[4][2];
#pragma unroll
        for (int k = 0; k < 4; ++k) { const uint4* up = (const uint4*)(U + (size_t)scan_row(dir, b, k) * D + g * 16); cur[k][0] = up[0]; cur[k][1] = up[1]; }
        for (int i0 = 0; i0 < CTXL + SEQ; i0 += 4) {
            const int inext = i0 + 4 < CTXL + SEQ ? i0 + 4 : i0;
#pragma unroll
            for (int k = 0; k < 4; ++k) { const uint4* up = (const uint4*)(U + (size_t)scan_row(dir, b, inext + k) * D + g * 16); nxt[k][0] = up[0]; nxt[k][1] = up[1]; }
#pragma unroll
            for (int k = 0; k < 4; ++k) {
                const int row = scan_row(dir, b, i0 + k);
                float u[16];
                u[0] = bflo(cur[k][0].x); u[1] = bfhi(cur[k][0].x); u[2] = bflo(cur[k][0].y); u[3] = bfhi(cur[k][0].y); u[4] = bflo(cur[k][0].z); u[5] = bfhi(cur[k][0].z); u[6] = bflo(cur[k][0].w); u[7] = bfhi(cur[k][0].w);
                u[8] = bflo(cur[k][1].x); u[9] = bfhi(cur[k][1].x); u[10] = bflo(cur[k][1].y); u[11] = bfhi(cur[k][1].y); u[12] = bflo(cur[k][1].z); u[13] = bfhi(cur[k][1].z); u[14] = bflo(cur[k][1].w); u[15] = bfhi(cur[k][1].w);
                float bur = 0.f, bui = 0.f;
#pragma unroll
                for (int c = 0; c < 16; ++c) { bur += Bre[c] * u[c]; bui += Bim[c] * u[c]; }
                const float nhr = abr * hr - abi * hi + bur, nhi = abr * hi + abi * hr + bui; hr = nhr; hi = nhi;
                float v[16];
#pragma unroll
                for (int c = 0; c < 16; ++c) v[c] = Cre[c] * hr - Cim[c] * hi;
                float r8[8], r4[4], r2[2], r1;
                { const bool up = (lane & 32) != 0;
#pragma unroll
                  for (int e = 0; e < 8; ++e) { const float keep = up ? v[e + 8] : v[e], send = up ? v[e] : v[e + 8]; r8[e] = keep + __shfl_xor(send, 32); } }
                { const bool up = (lane & 16) != 0;
#pragma unroll
                  for (int e = 0; e < 4; ++e) { const float keep = up ? r8[e + 4] : r8[e], send = up ? r8[e] : r8[e + 4]; r4[e] = keep + __shfl_xor(send, 16); } }
                { const bool up = (lane & 8) != 0;
#pragma unroll
                  for (int e = 0; e < 2; ++e) { const float keep = up ? r4[e + 2] : r4[e], send = up ? r4[e] : r4[e + 2]; r2[e] = keep + __shfl_xor(send, 8); } }
                { const bool up = (lane & 4) != 0; const float keep = up ? r2[1] : r2[0], send = up ? r2[0] : r2[1]; r1 = keep + __shfl_xor(send, 4); }
                r1 += __shfl_xor(r1, 2); r1 += __shfl_xor(r1, 1);
                if ((lane & 3) == 0) { const int ch = ((lane >> 5) & 1) * 8 + ((lane >> 4) & 1) * 4 + ((lane >> 3) & 1) * 2 + ((lane >> 2) & 1); Yd[(size_t)row * D + g * 16 + ch] = r1; }
            }
#pragma unroll
            for (int k = 0; k < 4; ++k) { cur[k][0] = nxt[k][0]; cur[k][1] = nxt[k][1]; }
        }
    }
}
__device__ __forceinline__ float gelu_tanh(float x) { const float z = 0.7978845608028654f * (x + 0.044715f * x * x * x); return 0.5f * x * (1.0f + tanhf(z)); }
__device__ __forceinline__ void combine_phase(const Ctx& C, const float* Y, const bf16* U, const float* dskip, bf16* Gout) {
    const size_t n4 = (size_t)MLAT * D / 4;
    for (size_t i = (size_t)C.gw * 64 + C.lane; i < n4; i += (size_t)C.NGW * 64) {
        const f32x4 yf = ((const f32x4*)Y)[i], yb = ((const f32x4*)(Y + (size_t)MALL * D))[i];
        const uint2 uw = ((const uint2*)U)[i]; const f32x4 u = (f32x4){bflo(uw.x), bfhi(uw.x), bflo(uw.y), bfhi(uw.y)};
        const f32x4 dd = ((const f32x4*)dskip)[i & (D / 4 - 1)];
        const f32x4 y = yf + yb + dd * u;
        uint2 w; w.x = pk2(gelu_tanh(y[0]), gelu_tanh(y[1])); w.y = pk2(gelu_tanh(y[2]), gelu_tanh(y[3]));
        ((uint2*)Gout)[i] = w;
    }
}

constexpr int NPHASE = 23;
#ifndef MK_ONE_LAUNCH
#define MK_ONE_LAUNCH 0
#endif
__global__ void __launch_bounds__(NWAVES * 64, 2) fwd_kernel(Args args) {
    extern __shared__ __attribute__((aligned(16))) unsigned char lds_raw[];
    Ctx C;
    C.lds = (LAS unsigned char*)lds_raw;
    C.tid = threadIdx.x; C.lane = C.tid & 63; C.wave = __builtin_amdgcn_readfirstlane(C.tid >> 6);
    C.G = gridDim.x; C.gw = (int)blockIdx.x * NWAVES + C.wave; C.NGW = C.G * NWAVES;
    C.in = args.in; C.out = args.out; C.ws = args.ws;
    volatile LAS unsigned* MISC = (volatile LAS unsigned*)(C.lds + MISC_OFF);
    for (int u = C.tid; u < (LDS_BYTES - 131072) / 4; u += NWAVES * 64) ((LAS unsigned*)(C.lds + 131072))[u] = 0u;
    __syncthreads();
    XcdBarrier bar; bar.bar = (unsigned*)(C.ws + WS_CTL) + CW_BAR; bar.x = 0; bar.st = nullptr;
    if (MK_ONE_LAUNCH) bar = xcd_barrier_post((unsigned*)(C.ws + WS_CTL) + CW_BAR, MISC + 8);
    const int lo = args.ph_lo, hi = args.ph_hi;
#define IN(k) (lo <= (k) && (k) < hi)
#define SEAM(k) do { if (IN(k) && IN((k) + 1)) xcd_barrier(bar); } while (0)
    unsigned char* ws = C.ws;
    bf16* HB = (bf16*)(ws + WS_H); bf16* OUTB = (bf16*)(ws + WS_OUT); bf16* ACTB = (bf16*)(ws + WS_ACT);
    bf16* QB = (bf16*)(ws + WS_Q); bf16* KB = (bf16*)(ws + WS_K); bf16* VB = (bf16*)(ws + WS_V); bf16* UB = (bf16*)(ws + WS_U);
    float* YB = (float*)(ws + WS_Y); float* XCTX = (float*)(ws + WS_XCTX);
    const float* x_in = C.in[0]; const float* ctx_in = C.in[2];
#define WIN(i) ((const bf16*)(ws + WS_WIN + (size_t)(i) * WIN_STRIDE))
#define WOUT(i) ((const bf16*)(ws + WS_WOUT + (size_t)(i) * WOUT_STRIDE))
#define GEMM_PHASE(EPI_T, EPI, Aptr, Btptr, M_, N_, K_) do { pg8::Gemm g_{(Aptr), (Btptr), (M_), (N_), (K_)}; pg8::StaticOrder S_; S_.init((M_), (N_), C.G, (int)blockIdx.x); \
        pg8::gemm_phase<EPI_T, pg8::StaticOrder, true, true>(C.lds, g_, S_, (EPI)); } while (0)

    if (IN(0)) { p0_prologue(C); } SEAM(0);
    if (IN(1)) { thin_phase(C, false, 0, 0, 0, 0.f, true, 0, 0, 0, 1, x_in, ctx_in, nullptr, nullptr, MALL); } SEAM(1);
    if (IN(2)) { pg8::EpiGated<0> E{ACTB, FF}; GEMM_PHASE(pg8::EpiGated<0>, E, HB, WIN(0), MALL, 2 * FF, D); } SEAM(2);
    if (IN(3)) { pg8::EpiPlain E{OUTB, D}; GEMM_PHASE(pg8::EpiPlain, E, ACTB, WOUT(0), MALL, D, FF); } SEAM(3);
    if (IN(4)) { thin_phase(C, true, 0, 1, 2, 0.5f, true, 0, 2, 3, 4, x_in, ctx_in, C.out, XCTX, MALL); } SEAM(4);
    if (IN(5)) { pg8::EpiQKV E{QB, KB, VB, (const float*)(ws + WS_ROPE), 0.08838834764831845f}; GEMM_PHASE(pg8::EpiQKV, E, HB, (const bf16*)(ws + WS_WQKV), MALL, 3072, D); } SEAM(5);
    if (IN(6)) { attn_simple(C, QB, KB, VB, C.in[11], HB, MALL); } SEAM(6);
    if (IN(7)) { pg8::EpiPlain E{OUTB, D}; GEMM_PHASE(pg8::EpiPlain, E, HB, (const bf16*)(ws + WS_WO), MALL, D, D); } SEAM(7);
    if (IN(8)) { thin_phase(C, true, 0, 3, 5, 1.0f, true, 0, 4, 6, 7, C.out, XCTX, C.out, XCTX, MALL); } SEAM(8);
    if (IN(9)) { pg8::EpiGated<0> E{ACTB, FF}; GEMM_PHASE(pg8::EpiGated<0>, E, HB, WIN(1), MALL, 2 * FF, D); } SEAM(9);
    if (IN(10)) { pg8::EpiPlain E{OUTB, D}; GEMM_PHASE(pg8::EpiPlain, E, ACTB, WOUT(1), MALL, D, FF); } SEAM(10);
    if (IN(11)) { thin_phase(C, true, 0, 5, 8, 0.5f, true, 1, 0, 0, 1, C.out, XCTX, C.out, XCTX, MALL); } SEAM(11);
    if (IN(12)) { pg8::EpiGated<0> E{ACTB, FF}; GEMM_PHASE(pg8::EpiGated<0>, E, HB, WIN(2), MALL, 2 * FF, D); } SEAM(12);
    if (IN(13)) { pg8::EpiPlain E{OUTB, D}; GEMM_PHASE(pg8::EpiPlain, E, ACTB, WOUT(2), MALL, D, FF); } SEAM(13);
    if (IN(14)) { thin_phase(C, true, 1, 1, 2, 0.5f, true, 1, 2, 3, 4, C.out, XCTX, C.out, XCTX, MALL); } SEAM(14);
    if (IN(15)) { pg8::EpiPlain E{UB, D}; GEMM_PHASE(pg8::EpiPlain, E, HB, (const bf16*)(ws + WS_WSIN), MALL, D, D); } SEAM(15);
    if (IN(16)) { scan_simple(C, UB, YB); } SEAM(16);
    if (IN(17)) { combine_phase(C, YB, UB, C.in[20], HB); } SEAM(17);
    if (IN(18)) { pg8::EpiGated<1> E{OUTB, D}; GEMM_PHASE(pg8::EpiGated<1>, E, HB, (const bf16*)(ws + WS_WGLU), MLAT, 4096, D); } SEAM(18);
    if (IN(19)) { thin_phase(C, true, 1, 3, 5, 1.0f, true, 1, 4, 6, 7, C.out, XCTX, C.out, XCTX, MLAT); } SEAM(19);
    if (IN(20)) { pg8::EpiGated<0> E{ACTB, FF}; GEMM_PHASE(pg8::EpiGated<0>, E, HB, WIN(3), MLAT, 2 * FF, D); } SEAM(20);
    if (IN(21)) { pg8::EpiPlain E{OUTB, D}; GEMM_PHASE(pg8::EpiPlain, E, ACTB, WOUT(3), MLAT, D, FF); } SEAM(21);
    if (IN(22)) { thin_phase(C, true, 1, 5, 8, 0.5f, false, 0, 0, 0, 0, C.out, XCTX, C.out, XCTX, MLAT); }
#undef IN
#undef SEAM
}

extern "C" void kernel_launch(void* const* d_in, const int* in_sizes, int n_in, void* d_out, int out_size, void* d_ws, size_t ws_size, hipStream_t stream) {
    static int grid = 0;
    if (grid == 0) {
        if (n_in != 22 || out_size != MLAT * D || ws_size < WS_END) { fprintf(stderr, "kernel_launch: unexpected shapes (n_in %d, out %d, ws %zu)\n", n_in, out_size, ws_size); grid = -1; return; }
        int dev = 0, cus = 0, per_cu = 0;
        if (hipGetDevice(&dev) != hipSuccess || hipDeviceGetAttribute(&cus, hipDeviceAttributeMultiprocessorCount, dev) != hipSuccess) { grid = -1; return; }
        if (hipFuncSetAttribute((const void*)fwd_kernel, hipFuncAttributeMaxDynamicSharedMemorySize, LDS_BYTES) != hipSuccess) { fprintf(stderr, "kernel_launch: hipFuncSetAttribute failed\n"); grid = -1; return; }
        if (hipOccupancyMaxActiveBlocksPerMultiprocessor(&per_cu, (const void*)fwd_kernel, NWAVES * 64, LDS_BYTES) != hipSuccess || per_cu < 1) fprintf(stderr, "kernel_launch: occupancy query says %d\n", per_cu);
        (void)hipGetLastError();
        grid = cus;
    }
    if (grid < 0) return;
    (void)hipMemsetAsync((char*)d_ws + WS_CTL, 0, CTL_ZERO_BYTES, stream);
    Args a{};
    for (int i = 0; i < 22; ++i) a.in[i] = (const float*)d_in[i];
    a.out = (float*)d_out; a.ws = (unsigned char*)d_ws;
#if MK_ONE_LAUNCH
    a.ph_lo = 0; a.ph_hi = NPHASE;
    hipLaunchKernelGGL(fwd_kernel, dim3(grid), dim3(NWAVES * 64), LDS_BYTES, stream, a);
#else
    for (int p = 0; p < NPHASE; ++p) { a.ph_lo = p; a.ph_hi = p + 1; hipLaunchKernelGGL(fwd_kernel, dim3(grid), dim3(NWAVES * 64), LDS_BYTES, stream, a); }
#endif
}
```

```cpp
#include <hip/hip_runtime.h>
#include <cstdio>
#include <cstdint>
namespace pg8 {
#define PG8_LAS __attribute__((address_space(3)))
typedef unsigned short bf16_t;
typedef short bf16x8 __attribute__((ext_vector_type(8)));
typedef float f32x4 __attribute__((ext_vector_type(4)));
typedef unsigned u32x4 __attribute__((ext_vector_type(4)));
constexpr int BM = 256, BK = 64, HALF = 128, HTB = HALF * BK * 2  , STAGE_BYTES = 8 * HTB, NXCD = 8, WGM = 8;

__host__ __device__ __forceinline__ int lds_byte(int r, int c) { const int st = (r >> 4) * 2 + (c >> 5), rr = r & 15, cc = c & 31, ob = rr * 64 + cc * 2; return st * 1024 + (ob ^ (((ob >> 9) & 1) << 5)); }
__host__ __device__ __forceinline__ void stage_rc(int b, int& R, int& C) { const int st = b / 1024, sb = b % 1024, swz = sb ^ (((sb >> 9) & 1) << 5); R = (st >> 1) * 16 + swz / 64; C = (st & 1) * 32 + (swz % 64) / 2; }
__host__ __device__ __forceinline__ int perm32(int rho) { const int n = rho >> 4, i = rho & 15; return 8 * (i >> 2) + 4 * n + (i & 3); }

struct Unit { int pm, pn, ks; };
struct Gemm { const bf16_t* A; const bf16_t* Bt; int M, N, K, ld, kchunk; };

struct StaticOrder {
    int nM, nN, nwg, G, c, wgm, rev;
    __host__ __device__ void init(int M, int N, int G_, int c_, int wgm_ = WGM, int rev_ = 0) { nM = M / BM; nN = N / BM; nwg = nM * nN; G = G_; c = c_; wgm = wgm_; rev = rev_; }
    __host__ __device__ bool next(int i, Unit& u) const {
        const long L = (long)i * G + c; if (L >= nwg) return false;
        const int nMa = (nM / (wgm * NXCD)) * (wgm * NXCD), nwga = nMa * nN;
        if (nMa > 0 && nMa < nM) {
            if (L >= nwga) { const int e = (int)L - nwga, nMr = nM - nMa; u.pm = nMa + e % nMr; u.pn = e / nMr; u.ks = 0; return true; }
            int wgid = (int)L; { const int q = nwga / NXCD, xcd = wgid % NXCD; int off = wgid / NXCD; if (rev) off = q - 1 - off; wgid = xcd * q + off; }
            const int nig = wgm * nN, gid = wgid / nig, fm = gid * wgm;
            u.pm = fm + ((wgid % nig) % wgm); u.pn = (wgid % nig) / wgm; u.ks = 0; return true;
        }
        int wgid = (int)L; { const int q = nwg / NXCD, r = nwg % NXCD, xcd = wgid % NXCD; int off = wgid / NXCD; if (rev) off = (xcd < r ? q + 1 : q) - 1 - off; wgid = (xcd < r ? xcd * (q + 1) : r * (q + 1) + (xcd - r) * q) + off; }
        const int nig = wgm * nN, gid = wgid / nig, fm = gid * wgm, gsz = (nM - fm) < wgm ? (nM - fm) : wgm;
        u.pm = fm + ((wgid % nig) % gsz); u.pn = (wgid % nig) / gsz; u.ks = 0; return true;
    }
    __device__ __forceinline__ void a_ready(const Unit&) const {}
    __device__ __forceinline__ void done(const Unit&) const {}
};

struct SplitKOrder {
    int pm0, npm, nN, nks, G, c;
    __host__ __device__ void init(int pm0_, int npm_, int N, int nks_, int G_, int c_) { pm0 = pm0_; npm = npm_; nN = N / BM; nks = nks_; G = G_; c = c_; }
    __host__ __device__ bool next(int i, Unit& u) const {
        const int L = i * G + c; if (L >= npm * nN * nks) return false;
        u.ks = L % nks; const int t = L / nks; u.pn = t % nN; u.pm = pm0 + t / nN; return true;
    }
    __device__ __forceinline__ void a_ready(const Unit&) const {}
    __device__ __forceinline__ void done(const Unit&) const {}
};

__device__ __forceinline__ unsigned cvt_pk_bf16(float lo, float hi) { unsigned r; asm volatile("v_cvt_pk_bf16_f32 %0, %1, %2" : "=v"(r) : "v"(lo), "v"(hi)); return r; }

template <class Epi, class Sched, bool ALIGN_EPI = false, bool SP2 = false>
__device__ __forceinline__ void gemm_phase(PG8_LAS unsigned char* lds, const Gemm g, const Sched& S, const Epi& E) {
    const int tid = threadIdx.x, wid = __builtin_amdgcn_readfirstlane(tid >> 6), lane = tid & 63, wr = wid >> 2, wc = wid & 3, fr = lane & 15, fq = lane >> 4;
    const int K = g.ld, nt = g.K / BK; const size_t kcb = (size_t)g.kchunk * 2;
    unsigned voffA[2], voffB[2];
#pragma unroll
    for (int i = 0; i < 2; ++i) { int R, C; stage_rc(tid * 16 + i * 8192, R, C); const int Rb = Epi::PERM ? ((R & ~31) + perm32(R & 31)) : R;
        voffA[i] = (unsigned)(R * K + C) * 2u; voffB[i] = (unsigned)(Rb * K + C) * 2u; }
    const size_t kstep = (size_t)(BK * 2);
    const size_t hstep = (size_t)HALF * K * 2;
    const size_t tstep = 2 * hstep;
    const unsigned ldsw = (unsigned)wid * 1024u;
    const int aoff = lds_byte(wr * 64 + fr, fq * 8), boff = lds_byte(wc * 32 + fr, fq * 8);
#define PG8_SA(b, h) (((b) * 2 + (h)) * HTB)
#define PG8_SB(b, h) ((4 + (b) * 2 + (h)) * HTB)
#define PG8_STAGE(bufoff, gbase, voff) do { _Pragma("unroll") for (int _i = 0; _i < 2; ++_i) \
        __builtin_amdgcn_global_load_lds((const unsigned*)((const char*)(gbase) + (voff)[_i]), (PG8_LAS unsigned*)(lds + (bufoff) + ldsw + _i * 8192), 16, 0, 0); } while (0)
#define PG8_LDA(dst, b, h) do { _Pragma("unroll") for (int m = 0; m < 4; ++m) _Pragma("unroll") for (int k = 0; k < 2; ++k) dst[m][k] = *(const PG8_LAS bf16x8*)(lds + PG8_SA(b, h) + aoff + m * 2048 + k * 1024); } while (0)
#define PG8_LDB(dst, b, h) do { _Pragma("unroll") for (int n = 0; n < 2; ++n) _Pragma("unroll") for (int k = 0; k < 2; ++k) dst[n][k] = *(const PG8_LAS bf16x8*)(lds + PG8_SB(b, h) + boff + n * 2048 + k * 1024); } while (0)
#define PG8_MMA(ai, bj, At, Bt) do { __builtin_amdgcn_s_setprio(1); _Pragma("unroll") for (int m = 0; m < 4; ++m) _Pragma("unroll") for (int n = 0; n < 2; ++n) _Pragma("unroll") for (int k = 0; k < 2; ++k) \
        acc[ai][bj][m][n] = __builtin_amdgcn_mfma_f32_16x16x32_bf16(Bt[n][k], At[m][k], acc[ai][bj][m][n], 0, 0, 0); __builtin_amdgcn_s_setprio(0); } while (0)
#define PG8_WAIT_V(n) asm volatile("s_waitcnt vmcnt(" #n ")" ::: "memory")
#define PG8_WAIT_L(n) asm volatile("s_waitcnt lgkmcnt(" #n ")" ::: "memory")
#define PG8_BAR __builtin_amdgcn_s_barrier()
#define PG8_SCHED __builtin_amdgcn_sched_barrier(0)
    Unit cur, nxt; int ui = 0;
    if (!S.next(0, cur)) return;
    f32x4 acc[2][2][4][2];
#pragma unroll
    for (int a = 0; a < 2; ++a)
#pragma unroll
        for (int b = 0; b < 2; ++b)
#pragma unroll
            for (int m = 0; m < 4; ++m)
#pragma unroll
                for (int n = 0; n < 2; ++n) acc[a][b][m][n] = (f32x4){0.f, 0.f, 0.f, 0.f};
    bf16x8 At[4][2], B0[2][2], B1[2][2];
    const char* cA = (const char*)g.A + (size_t)cur.pm * tstep + (size_t)cur.ks * kcb; const char* cB = (const char*)g.Bt + (size_t)cur.pn * tstep + (size_t)cur.ks * kcb;
    S.a_ready(cur);
    if constexpr (SP2) {
        PG8_STAGE(PG8_SB(0, 0), cB, voffB); PG8_STAGE(PG8_SB(0, 1), cB + hstep, voffB); PG8_STAGE(PG8_SA(0, 0), cA, voffA); PG8_STAGE(PG8_SA(0, 1), cA + hstep, voffA);
        if (wr == 1) PG8_BAR;
        PG8_WAIT_V(2); PG8_BAR;
        PG8_STAGE(PG8_SB(1, 0), cB + kstep, voffB); PG8_STAGE(PG8_SA(1, 0), cA + kstep, voffA); PG8_STAGE(PG8_SB(1, 1), cB + hstep + kstep, voffB);
        PG8_WAIT_V(6); PG8_BAR;
    } else {
        PG8_STAGE(PG8_SB(0, 0), cB, voffB); PG8_STAGE(PG8_SA(0, 0), cA, voffA); PG8_STAGE(PG8_SB(0, 1), cB + hstep, voffB); PG8_STAGE(PG8_SA(0, 1), cA + hstep, voffA);
        if (wr == 1) PG8_BAR;
        PG8_WAIT_V(4); PG8_BAR;
        PG8_STAGE(PG8_SB(1, 0), cB + kstep, voffB); PG8_STAGE(PG8_SA(1, 0), cA + kstep, voffA); PG8_STAGE(PG8_SB(1, 1), cB + hstep + kstep, voffB);
        PG8_WAIT_V(6); PG8_BAR;
    }
    for (;;) {
        const bool has_next = S.next(ui + 1, nxt);
        const char* nA = has_next ? (const char*)g.A + (size_t)nxt.pm * tstep + (size_t)nxt.ks * kcb : cA; const char* nB = has_next ? (const char*)g.Bt + (size_t)nxt.pn * tstep + (size_t)nxt.ks * kcb : cB;
        for (int t = 0; t < nt; t += 2) {
            const bool last = (t == nt - 2);
            const char* a1 = cA + (size_t)(t + 1) * kstep;
            const char* a2 = last ? nA : cA + (size_t)(t + 2) * kstep; const char* b2 = last ? nB : cB + (size_t)(t + 2) * kstep;
            const char* a3 = a2 + kstep; const char* b3 = b2 + kstep;
            if (last && has_next) S.a_ready(nxt);
            if constexpr (SP2) {
            PG8_LDB(B0, 0, 0); PG8_LDB(B1, 0, 1); PG8_SCHED; PG8_LDA(At, 0, 0); PG8_STAGE(PG8_SA(1, 1), a1 + hstep, voffA);
            PG8_WAIT_V(8); PG8_WAIT_L(0); PG8_BAR; PG8_MMA(0, 0, At, B0); PG8_MMA(0, 1, At, B1); PG8_BAR; PG8_SCHED;
            PG8_LDA(At, 0, 1); PG8_STAGE(PG8_SB(0, 0), b2, voffB); PG8_STAGE(PG8_SB(0, 1), b2 + hstep, voffB); PG8_STAGE(PG8_SA(0, 0), a2, voffA);
            PG8_WAIT_V(8); PG8_WAIT_L(0); PG8_BAR; PG8_MMA(1, 0, At, B0); PG8_MMA(1, 1, At, B1); PG8_BAR; PG8_SCHED;
            PG8_LDB(B0, 1, 0); PG8_LDB(B1, 1, 1); PG8_SCHED; PG8_LDA(At, 1, 0); PG8_STAGE(PG8_SA(0, 1), a2 + hstep, voffA);
            PG8_WAIT_V(8); PG8_WAIT_L(0); PG8_BAR; PG8_MMA(0, 0, At, B0); PG8_MMA(0, 1, At, B1); PG8_BAR; PG8_SCHED;
            PG8_LDA(At, 1, 1); PG8_STAGE(PG8_SB(1, 0), b3, voffB); PG8_STAGE(PG8_SB(1, 1), b3 + hstep, voffB); PG8_STAGE(PG8_SA(1, 0), a3, voffA);
            PG8_WAIT_V(8); PG8_WAIT_L(0); PG8_BAR; PG8_MMA(1, 0, At, B0); PG8_MMA(1, 1, At, B1); PG8_BAR; PG8_SCHED;
            } else {
            PG8_LDB(B0, 0, 0); PG8_SCHED; PG8_LDA(At, 0, 0); PG8_STAGE(PG8_SA(1, 1), a1 + hstep, voffA);
            PG8_WAIT_L(8); PG8_BAR; PG8_WAIT_L(0); PG8_MMA(0, 0, At, B0); PG8_BAR; PG8_SCHED;
            PG8_LDB(B1, 0, 1); PG8_STAGE(PG8_SB(0, 0), b2, voffB);
            PG8_BAR; PG8_WAIT_L(0); PG8_MMA(0, 1, At, B1); PG8_BAR;
            PG8_LDA(At, 0, 1); PG8_STAGE(PG8_SA(0, 0), a2, voffA);
            PG8_BAR; PG8_WAIT_L(0); PG8_MMA(1, 0, At, B0); PG8_BAR; PG8_SCHED;
            PG8_STAGE(PG8_SB(0, 1), b2 + hstep, voffB);
            PG8_WAIT_V(6); PG8_BAR; PG8_MMA(1, 1, At, B1); PG8_BAR;
            PG8_LDB(B0, 1, 0); PG8_SCHED; PG8_LDA(At, 1, 0); PG8_STAGE(PG8_SA(0, 1), a2 + hstep, voffA);
            PG8_WAIT_L(8); PG8_BAR; PG8_WAIT_L(0); PG8_MMA(0, 0, At, B0); PG8_BAR; PG8_SCHED;
            PG8_LDB(B1, 1, 1); PG8_STAGE(PG8_SB(1, 0), b3, voffB);
            PG8_BAR; PG8_WAIT_L(0); PG8_MMA(0, 1, At, B1); PG8_BAR;
            PG8_LDA(At, 1, 1); PG8_STAGE(PG8_SA(1, 0), a3, voffA);
            PG8_BAR; PG8_WAIT_L(0); PG8_MMA(1, 0, At, B0); PG8_BAR; PG8_SCHED;
            PG8_STAGE(PG8_SB(1, 1), b3 + hstep, voffB);
            PG8_WAIT_V(6); PG8_BAR; PG8_MMA(1, 1, At, B1); PG8_BAR;
            }
        }
        if constexpr (ALIGN_EPI) { if (wr == 0) PG8_BAR; }
        if constexpr (!Epi::AFTER_DRAIN) { E(acc, cur, wr, wc, fr, fq); S.done(cur); }
        if (!has_next) break;
#pragma unroll
        for (int a = 0; a < 2; ++a)
#pragma unroll
            for (int b = 0; b < 2; ++b)
#pragma unroll
                for (int m = 0; m < 4; ++m)
#pragma unroll
                    for (int n = 0; n < 2; ++n) acc[a][b][m][n] = (f32x4){0.f, 0.f, 0.f, 0.f};
        cur = nxt; cA = nA; cB = nB; ++ui;
        if constexpr (ALIGN_EPI) { if (wr == 1) PG8_BAR; }
    }
    PG8_WAIT_V(0);
    if constexpr (!ALIGN_EPI) { if (wr == 0) PG8_BAR; }
    PG8_BAR;
    if constexpr (Epi::AFTER_DRAIN) { E.fused(acc, cur, wr, wc, fr, fq, lds, wid, lane); S.done(cur); }
#undef PG8_SA
#undef PG8_SB
#undef PG8_STAGE
#undef PG8_LDA
#undef PG8_LDB
#undef PG8_MMA
#undef PG8_WAIT_V
#undef PG8_WAIT_L
#undef PG8_BAR
#undef PG8_SCHED
}
}
#define GAS __attribute__((address_space(1)))
#define LAS __attribute__((address_space(3)))
typedef unsigned short bf16;
typedef unsigned v4u __attribute__((ext_vector_type(4)));
typedef float f32x4 __attribute__((ext_vector_type(4)));
typedef short bf16x8 __attribute__((ext_vector_type(8)));
typedef GAS unsigned gu32;
typedef GAS unsigned long long gu64;
#define RLX_AGENT __ATOMIC_RELAXED, __HIP_MEMORY_SCOPE_AGENT
#define LDS_WAIT() asm volatile("s_waitcnt lgkmcnt(0)" ::: "memory")
#define VM_WAIT() asm volatile("s_waitcnt vmcnt(0)" ::: "memory")
__device__ __forceinline__ unsigned long long rt() { return __builtin_amdgcn_s_memrealtime(); }
__device__ __forceinline__ unsigned f2bf(float f) { unsigned u = __builtin_bit_cast(unsigned, f); return (u + 0x7fffu + ((u >> 16) & 1u)) >> 16; }
__device__ __forceinline__ unsigned pk2(float lo, float hi) { return f2bf(lo) | (f2bf(hi) << 16); }

#define XB_TMO      128
#define XB_XCNT(j)  (256  + 64 * (j))
#define XB_XSUB(j)  (1280 + 64 * (j))
#define XB_XGEN(j)  (2304 + 64 * (j))
#define XB_TOP      3328
#define XB_TOPGEN   3392
#define XCD_BAR_WORDS 3456
#define XB_SPIN_CAP (1u << 18)

__device__ __forceinline__ unsigned xb_ld(unsigned* p)              { return __hip_atomic_load(p, __ATOMIC_RELAXED, __HIP_MEMORY_SCOPE_AGENT); }
__device__ __forceinline__ unsigned xb_add(unsigned* p, unsigned v) { return __hip_atomic_fetch_add(p, v, __ATOMIC_RELAXED, __HIP_MEMORY_SCOPE_AGENT); }
__device__ __forceinline__ unsigned xb_xcc_id() { return (unsigned)__builtin_amdgcn_s_getreg((3 << 11) | 20) & 0xFu; }
#define XB_SPIN(cond, bar) do { unsigned _sp = 0; while (cond) { __builtin_amdgcn_s_sleep(1); \
    if ((++_sp & 255u) == 0u) { if (xb_ld(&(bar)[XB_TMO])) break; if (_sp > XB_SPIN_CAP) { atomicAdd(&(bar)[XB_TMO], 1u); break; } } } } while (0)

struct XcdBarrier {
    unsigned* bar; unsigned x;
    volatile LAS unsigned* st;
};

__device__ __forceinline__ XcdBarrier xcd_barrier_post(unsigned* bar, volatile LAS unsigned* st) {
    XcdBarrier b; b.bar = bar; b.x = xb_xcc_id(); b.st = st;
    if (threadIdx.x == 0) (void)xb_add(&bar[XB_XCNT(b.x)], 1u);
    return b;
}
__device__ __forceinline__ void xcd_barrier_complete(unsigned* bar, unsigned x, unsigned& nloc, unsigned& nx) {
    const unsigned G = gridDim.x * gridDim.y * gridDim.z;
    unsigned sum, cnt, mine, sp = 0u;
    for (;;) {
        sum = 0u; cnt = 0u; mine = 0u;
#pragma unroll
        for (unsigned j = 0; j < 16; ++j) { const unsigned c = xb_ld(&bar[XB_XCNT(j)]); sum += c; cnt += (c > 0u) ? 1u : 0u; mine = (j == x) ? c : mine; }
        if (sum == G) break;
        __builtin_amdgcn_s_sleep(1);
        if ((++sp & 255u) == 0u) { if (xb_ld(&bar[XB_TMO])) break; if (sp > XB_SPIN_CAP) { atomicAdd(&bar[XB_TMO], 1u); break; } }
    }
    nloc = mine > 0u ? mine : 1u; nx = cnt > 0u ? cnt : 1u;
}

__device__ __forceinline__ void xcd_barrier(const XcdBarrier& b) {
    asm volatile("s_waitcnt vmcnt(0)" ::: "memory");
    __syncthreads();
    if (threadIdx.x == 0) {
        unsigned* bar = b.bar;
        __builtin_amdgcn_s_waitcnt(0);
        unsigned nloc = b.st[0], nx = b.st[1];
        if (nloc == 0u) { xcd_barrier_complete(bar, b.x, nloc, nx); b.st[0] = nloc; b.st[1] = nx; }
        const unsigned old = xb_add(&bar[XB_XSUB(b.x)], 1u);
        const unsigned gen = old / nloc;
        if (old + 1u == (gen + 1u) * nloc) {
            __builtin_amdgcn_fence(__ATOMIC_RELEASE, "agent");
            asm volatile("s_waitcnt vmcnt(0)" ::: "memory");
            const unsigned og = xb_add(&bar[XB_TOP], 1u);
            const unsigned tg = og / nx;
            if (og + 1u == (tg + 1u) * nx) xb_add(&bar[XB_TOPGEN], 1u);
            else XB_SPIN(xb_ld(&bar[XB_TOPGEN]) == tg, bar);
            __builtin_amdgcn_fence(__ATOMIC_ACQUIRE, "agent");
            xb_add(&bar[XB_XGEN(b.x)], 1u);
            asm volatile("s_waitcnt vmcnt(0)" ::: "memory");
        } else {
            XB_SPIN(xb_ld(&bar[XB_XGEN(b.x)]) == gen, bar);
            __builtin_amdgcn_fence(__ATOMIC_ACQUIRE, "agent");
            asm volatile("s_waitcnt vmcnt(0)" ::: "memory");
        }
    }
    __syncthreads();
}

constexpr int D = 2048, SEQ = 16384, NB = 2, CTXL = 256, FF = 5632;
constexpr int MLAT = NB * SEQ;
constexpr int MCTX = NB * CTXL;
constexpr int MALL = MLAT + MCTX;
constexpr int NMOD = 9 * D;
constexpr int KVD = 512;
constexpr float EPSN = 1e-6f;
constexpr int NWAVES = 8;

constexpr size_t MiB = 1u << 20;
constexpr size_t WS_CTL = 0, CTL_ZERO_BYTES = 2 * MiB;
constexpr size_t WS_MODS = 1 * MiB;
constexpr size_t WS_ROPE = 2 * MiB;
constexpr size_t WS_XCTX = 10 * MiB;
constexpr size_t WS_WIN = 16 * MiB, WIN_STRIDE = 44 * MiB;
constexpr size_t WS_WOUT = 192 * MiB, WOUT_STRIDE = 22 * MiB;
constexpr size_t WS_WQKV = 280 * MiB, WS_WO = 292 * MiB, WS_WSIN = 300 * MiB, WS_WGLU = 308 * MiB;
constexpr size_t WS_H = 324 * MiB;
constexpr size_t WS_OUT = 454 * MiB;
constexpr size_t WS_ACT = 584 * MiB;
constexpr size_t WS_Q = 942 * MiB, WS_K = 1072 * MiB, WS_V = 1105 * MiB;
constexpr size_t WS_U = 942 * MiB;
constexpr size_t WS_XB = 1138 * MiB;
constexpr size_t WS_Y = 584 * MiB;
constexpr size_t WS_PART = 1268 * MiB;
constexpr size_t WS_MODP = 1312 * MiB;
constexpr size_t WS_END = 1320 * MiB;
constexpr int CW_BAR = 4096;

constexpr int LDS_BYTES = 163840;
constexpr int MISC_OFF = 163840 - 256;

template <int CTRL> __device__ __forceinline__ float dppmov(float v) { return __int_as_float(__builtin_amdgcn_update_dpp(0, __float_as_int(v), CTRL, 0xf, 0xf, true)); }
__device__ __forceinline__ float wave_sum(float v) {
    v += dppmov<0xB1>(v);
    v += dppmov<0x4E>(v);
    v += dppmov<0x141>(v);
    v += dppmov<0x140>(v);
    v += __shfl_xor(v, 16);
    v += __shfl_xor(v, 32);
    return v;
}
__device__ __forceinline__ float wave_max(float v) {
#pragma unroll
    for (int o = 1; o < 64; o <<= 1) v = fmaxf(v, __shfl_xor(v, o));
    return v;
}
typedef unsigned tu32x2 __attribute__((ext_vector_type(2)));
typedef float tf32x2 __attribute__((ext_vector_type(2))); typedef __bf16 tbf16x2 __attribute__((ext_vector_type(2)));
__device__ __forceinline__ unsigned cvt2bf(float lo, float hi) { tf32x2 v = {lo, hi}; tbf16x2 b = __builtin_convertvector(v, tbf16x2); return __builtin_bit_cast(unsigned, b); }
__device__ __forceinline__ float bflo(unsigned w) { return __uint_as_float(w << 16); }
__device__ __forceinline__ float bfhi(unsigned w) { return __uint_as_float(w & 0xffff0000u); }

namespace pg8 {
struct EpiPartial {
    static constexpr bool PERM = false, AFTER_DRAIN = false;
    float* P; int ldc; int row_base; size_t slab;
    __device__ __forceinline__ void operator()(const f32x4 (&acc)[2][2][4][2], const Unit& u, int wr, int wc, int fr, int fq) const {
        const int row0 = u.pm * BM - row_base + wr * 64 + fr, col0 = u.pn * BM + wc * 32 + 4 * fq;
        float* base = P + (size_t)u.ks * slab;
#pragma unroll
        for (int ai = 0; ai < 2; ++ai)
#pragma unroll
            for (int m = 0; m < 4; ++m) { float* rowp = base + (size_t)(row0 + ai * HALF + m * 16) * ldc + col0;
#pragma unroll
                for (int bj = 0; bj < 2; ++bj)
#pragma unroll
                    for (int n = 0; n < 2; ++n) *(f32x4*)(rowp + bj * HALF + n * 16) = acc[ai][bj][m][n]; }
    }
};
struct EpiPlain {
    static constexpr bool PERM = true, AFTER_DRAIN = false;
    bf16_t* O; int ldc;
    __device__ __forceinline__ void operator()(const f32x4 (&acc)[2][2][4][2], const Unit& u, int wr, int wc, int fr, int fq) const {
        const int row0 = u.pm * BM + wr * 64 + fr, col0 = u.pn * BM + wc * 32 + 8 * fq;
#pragma unroll
        for (int ai = 0; ai < 2; ++ai)
#pragma unroll
            for (int m = 0; m < 4; ++m) { bf16_t* rowp = O + (size_t)(row0 + ai * HALF + m * 16) * ldc + col0;
#pragma unroll
                for (int bj = 0; bj < 2; ++bj) { const f32x4 v0 = acc[ai][bj][m][0], v1 = acc[ai][bj][m][1];
                    u32x4 w; w.x = cvt_pk_bf16(v0[0], v0[1]); w.y = cvt_pk_bf16(v0[2], v0[3]); w.z = cvt_pk_bf16(v1[0], v1[1]); w.w = cvt_pk_bf16(v1[2], v1[3]);
                    *(u32x4*)(rowp + bj * HALF) = w; } }
    }
};
template <int MODE> struct EpiGated {
    static constexpr bool PERM = true, AFTER_DRAIN = false;
    bf16_t* O; int ldc;
    __device__ __forceinline__ void operator()(const f32x4 (&acc)[2][2][4][2], const Unit& u, int wr, int wc, int fr, int fq) const {
        const int row0 = u.pm * BM + wr * 64 + fr, col0 = u.pn * (BM / 2) + wc * 16 + 4 * (fq & ~1);
#pragma unroll
        for (int ai = 0; ai < 2; ++ai)
#pragma unroll
            for (int mp = 0; mp < 2; ++mp) {
                bf16_t* rowp = O + (size_t)(row0 + ai * HALF + (2 * mp + (fq & 1)) * 16) * ldc + col0;
#pragma unroll
                for (int bj = 0; bj < 2; ++bj) {
                    unsigned pw[2][2];
#pragma unroll
                    for (int mm = 0; mm < 2; ++mm) { const f32x4 v0 = acc[ai][bj][2 * mp + mm][0], v1 = acc[ai][bj][2 * mp + mm][1];
#pragma unroll
                        for (int e2 = 0; e2 < 2; ++e2) { typedef float f2 __attribute__((ext_vector_type(2)));
                            const f2 a = {v0[2 * e2], v0[2 * e2 + 1]}, b = {v1[2 * e2], v1[2 * e2 + 1]};
                            const f2 t = (MODE == 0 ? a : b) * (f2){-1.4426950408889634f, -1.4426950408889634f};
                            const f2 den = (f2){__builtin_amdgcn_exp2f(t[0]), __builtin_amdgcn_exp2f(t[1])} + (f2){1.0f, 1.0f};
                            const f2 rc = {__builtin_amdgcn_rcpf(den[0]), __builtin_amdgcn_rcpf(den[1])};
                            f2 r = a * rc; if (MODE == 0) r = r * b;
                            pw[mm][e2] = cvt_pk_bf16(r[0], r[1]); } }
                    const auto sx = __builtin_amdgcn_permlane16_swap(pw[0][0], pw[1][0], false, false);
                    const auto sy = __builtin_amdgcn_permlane16_swap(pw[0][1], pw[1][1], false, false);
                    u32x4 w; w.x = sx[0]; w.y = sy[0]; w.z = sx[1]; w.w = sy[1];
                    *(u32x4*)(rowp + bj * (HALF / 2)) = w; } }
    }
};
struct EpiQKV {
    static constexpr bool PERM = true, AFTER_DRAIN = false;
    bf16_t* Q; bf16_t* K; bf16_t* V; const float* rope; float qscale;
    __device__ __forceinline__ void operator()(const f32x4 (&acc)[2][2][4][2], const Unit& u, int wr, int wc, int fr, int fq) const {
        const int row0 = u.pm * BM + wr * 64 + fr; const int pn = u.pn;
        if (pn >= 10) {
            const int col0 = (pn - 10) * BM + wc * 32 + 8 * fq;
#pragma unroll
            for (int ai = 0; ai < 2; ++ai)
#pragma unroll
                for (int m = 0; m < 4; ++m) { bf16_t* rowp = V + (size_t)(row0 + ai * HALF + m * 16) * KVD + col0;
#pragma unroll
                    for (int bj = 0; bj < 2; ++bj) { const f32x4 v0 = acc[ai][bj][m][0], v1 = acc[ai][bj][m][1];
                        u32x4 w; w.x = cvt_pk_bf16(v0[0], v0[1]); w.y = cvt_pk_bf16(v0[2], v0[3]); w.z = cvt_pk_bf16(v1[0], v1[1]); w.w = cvt_pk_bf16(v1[2], v1[3]);
                        *(u32x4*)(rowp + bj * HALF) = w; } }
            return;
        }
        const bool isq = pn < 8; const bool lat = u.pm < (MLAT / BM);
        const float sc = isq ? qscale : 1.0f;
        const int tcol = (wc >> 1) * 32 + 16 * (wc & 1) + 4 * fq;
#pragma unroll
        for (int ai = 0; ai < 2; ++ai)
#pragma unroll
            for (int m = 0; m < 4; ++m) {
                const int row = row0 + ai * HALF + m * 16;
                f32x4 t0 = (f32x4){1.f, 0.f, 1.f, 0.f}, t1 = (f32x4){1.f, 0.f, 1.f, 0.f};
                if (lat) { const f32x4* tp = (const f32x4*)(rope + ((size_t)(row & (SEQ - 1)) * 64 + tcol) * 2); t0 = tp[0]; t1 = tp[1]; }
#pragma unroll
                for (int bj = 0; bj < 2; ++bj) { const f32x4 v0 = acc[ai][bj][m][0], v1 = acc[ai][bj][m][1];
                    const float a0 = (v0[0] * t0[0] - v0[1] * t0[1]) * sc, a1 = (v0[1] * t0[0] + v0[0] * t0[1]) * sc;
                    const float a2 = (v0[2] * t0[2] - v0[3] * t0[3]) * sc, a3 = (v0[3] * t0[2] + v0[2] * t0[3]) * sc;
                    const float b0 = (v1[0] * t1[0] - v1[1] * t1[1]) * sc, b1 = (v1[1] * t1[0] + v1[0] * t1[1]) * sc;
                    const float b2 = (v1[2] * t1[2] - v1[3] * t1[3]) * sc, b3 = (v1[3] * t1[2] + v1[2] * t1[3]) * sc;
                    u32x4 w; w.x = cvt_pk_bf16(a0, a1); w.y = cvt_pk_bf16(a2, a3); w.z = cvt_pk_bf16(b0, b1); w.w = cvt_pk_bf16(b2, b3);
                    bf16_t* dst = isq ? Q + (size_t)row * D + (pn * 2 + bj) * 128 + wc * 32 + 8 * fq
                                      : K + (size_t)row * KVD + ((pn - 8) * 2 + bj) * 128 + wc * 32 + 8 * fq;
                    *(u32x4*)dst = w; } }
    }
};
struct EpiUg {
    static constexpr bool PERM = true, AFTER_DRAIN = false;
    bf16_t* Ug;
    __device__ __forceinline__ void operator()(const f32x4 (&acc)[2][2][4][2], const Unit& u, int wr, int wc, int fr, int fq) const {
        const int b = u.pm < (MLAT / BM) ? (u.pm >> 6) : (u.pm - MLAT / BM);
        const int tok0 = u.pm < (MLAT / BM) ? CTXL + (u.pm & 63) * BM : 0;
#pragma unroll
        for (int ai = 0; ai < 2; ++ai)
#pragma unroll
            for (int m = 0; m < 4; ++m) { const int tok = tok0 + ai * HALF + wr * 64 + m * 16 + fr;
#pragma unroll
                for (int bj = 0; bj < 2; ++bj) { const f32x4 v0 = acc[ai][bj][m][0], v1 = acc[ai][bj][m][1];
                    const int g = 16 * u.pn + 8 * bj + 2 * wc + (fq >> 1);
                    u32x4 w; w.x = cvt_pk_bf16(v0[0], v0[1]); w.y = cvt_pk_bf16(v0[2], v0[3]); w.z = cvt_pk_bf16(v1[0], v1[1]); w.w = cvt_pk_bf16(v1[2], v1[3]);
                    *(u32x4*)(Ug + ((size_t)(b * 128 + g) * (CTXL + SEQ) + tok) * 16 + (fq & 1) * 8) = w; } }
    }
};
}

struct Args { const float* in[22]; float* out; unsigned char* ws; int ph_lo, ph_hi; };
struct Ctx {
    LAS unsigned char* lds;
    int tid, lane, wave, G, gw, NGW;
    const float* const* in;
    float* out; unsigned char* ws;
};

__device__ __forceinline__ int map_row(int mode, int n, int N) {
    if (mode == 1) { const int half = N >> 1; const int hi = n >= half ? 1 : 0; const int j = n - hi * half; return ((j >> 2) << 3) + hi * 4 + (j & 3); }
    if (mode == 2) { if (n >= 2560) return n; const int head = n >> 7, d = n & 127, a = d >> 6, dd = d & 63, which = dd >> 5, i = dd & 31; return (head << 7) + (a << 6) + 2 * i + which; }
    return n;
}
__device__ __forceinline__ void transpose_item(const float* W, int K, int N, bf16* WT, int mode, LAS float* scr, int item, int lane) {
    const int nblk = N / 32, kb = item / nblk, nb = item % nblk, k0 = 64 * kb, n0 = 32 * nb;
    float v[32];
#pragma unroll
    for (int i = 0; i < 32; ++i) v[i] = __builtin_nontemporal_load(W + (size_t)(k0 + 2 * i + (lane >> 5)) * N + n0 + (lane & 31));
#pragma unroll
    for (int i = 0; i < 32; ++i) scr[(2 * i + (lane >> 5)) * 33 + (lane & 31)] = v[i];
    LDS_WAIT(); asm volatile("" ::: "memory");
    const int c = lane & 7;
#pragma unroll
    for (int j = 0; j < 4; ++j) { const int n = (lane >> 3) + 8 * j; const LAS float* s = scr + (8 * c) * 33 + n;
        v4u o; o.x = cvt2bf(s[0 * 33], s[1 * 33]); o.y = cvt2bf(s[2 * 33], s[3 * 33]); o.z = cvt2bf(s[4 * 33], s[5 * 33]); o.w = cvt2bf(s[6 * 33], s[7 * 33]);
        *(v4u*)(WT + (size_t)map_row(mode, n0 + n, N) * K + k0 + 8 * c) = o; }
    LDS_WAIT(); asm volatile("" ::: "memory");
}
__device__ __forceinline__ float siluf(float x) { return x / (1.0f + __expf(-x)); }

constexpr int I_WIN = (D / 64) * (2 * FF / 32), I_WOUT = (FF / 64) * (D / 32), I_QKV = (D / 64) * (3072 / 32), I_SQ = (D / 64) * (D / 32), I_GLU = (D / 64) * (4096 / 32);
constexpr int CV_WIN0 = 0, CV_WOUT0 = CV_WIN0 + I_WIN, CV_WQKV = CV_WOUT0 + I_WOUT, CV_WO = CV_WQKV + I_QKV, CV_WIN1 = CV_WO + I_SQ, CV_WOUT1 = CV_WIN1 + I_WIN, CV_WIN2 = CV_WOUT1 + I_WOUT,
              CV_WOUT2 = CV_WIN2 + I_WIN, CV_WSIN = CV_WOUT2 + I_WOUT, CV_WGLU = CV_WSIN + I_SQ, CV_WIN3 = CV_WGLU + I_GLU, CV_WOUT3 = CV_WIN3 + I_WIN, CV_END = CV_WOUT3 + I_WOUT;
static_assert(CV_END == 78848, "item count");
constexpr int CV_S2_B = CV_WOUT0, CV_S2_E = CV_WIN1;
constexpr int CV_S5_B = CV_WIN1, CV_S5_E = CV_WIN1 + 14848;
constexpr int CV_S9_B = CV_S5_E, CV_S9_E = CV_S5_E + 10752;
constexpr int CV_P0B_B = CV_S9_E, CV_P0B_E = CV_WOUT2;
constexpr int CV_S12_B = CV_WOUT2, CV_S12_E = CV_WOUT2 + 10752;
constexpr int CV_S15_B = CV_S12_E, CV_S15_E = CV_S12_E + 14848;
constexpr int CV_P0C_B = CV_S15_E, CV_P0C_E = CV_END;
static_assert(CV_S5_E <= CV_WIN2 && CV_S9_E <= CV_WOUT2 && CV_S9_E >= CV_WIN2 && CV_S12_E <= CV_WIN3 && CV_S12_E >= CV_WGLU && CV_S15_E <= CV_END && CV_S15_E >= CV_WOUT3, "slot map");
__device__ __forceinline__ void convert_items(const Ctx& C, const int begin, const int end, const int rank, const int nranks) {
    LAS float* scr = (LAS float*)(C.lds + C.wave * 16384);
    for (int it = begin + rank * NWAVES + C.wave; it < end; it += nranks * NWAVES) {
        int r = it; const float* W; int K, N, mode; bf16* WT;
        if (r < CV_WOUT0) { W = C.in[7]; K = D; N = 2 * FF; mode = 1; WT = (bf16*)(C.ws + WS_WIN); }
        else if (r < CV_WQKV) { r -= CV_WOUT0; W = C.in[8]; K = FF; N = D; mode = 0; WT = (bf16*)(C.ws + WS_WOUT); }
        else if (r < CV_WO) { r -= CV_WQKV; W = C.in[9]; K = D; N = 3072; mode = 2; WT = (bf16*)(C.ws + WS_WQKV); }
        else if (r < CV_WIN1) { r -= CV_WO; W = C.in[10]; K = D; N = D; mode = 0; WT = (bf16*)(C.ws + WS_WO); }
        else if (r < CV_WOUT1) { r -= CV_WIN1; W = C.in[7] + (size_t)1 * D * 2 * FF; K = D; N = 2 * FF; mode = 1; WT = (bf16*)(C.ws + WS_WIN + 1 * WIN_STRIDE); }
        else if (r < CV_WIN2) { r -= CV_WOUT1; W = C.in[8] + (size_t)1 * FF * D; K = FF; N = D; mode = 0; WT = (bf16*)(C.ws + WS_WOUT + 1 * WOUT_STRIDE); }
        else if (r < CV_WOUT2) { r -= CV_WIN2; W = C.in[7] + (size_t)2 * D * 2 * FF; K = D; N = 2 * FF; mode = 1; WT = (bf16*)(C.ws + WS_WIN + 2 * WIN_STRIDE); }
        else if (r < CV_WSIN) { r -= CV_WOUT2; W = C.in[8] + (size_t)2 * FF * D; K = FF; N = D; mode = 0; WT = (bf16*)(C.ws + WS_WOUT + 2 * WOUT_STRIDE); }
        else if (r < CV_WGLU) { r -= CV_WSIN; W = C.in[12]; K = D; N = D; mode = 0; WT = (bf16*)(C.ws + WS_WSIN); }
        else if (r < CV_WIN3) { r -= CV_WGLU; W = C.in[21]; K = D; N = 4096; mode = 1; WT = (bf16*)(C.ws + WS_WGLU); }
        else if (r < CV_WOUT3) { r -= CV_WIN3; W = C.in[7] + (size_t)3 * D * 2 * FF; K = D; N = 2 * FF; mode = 1; WT = (bf16*)(C.ws + WS_WIN + 3 * WIN_STRIDE); }
        else { r -= CV_WOUT3; W = C.in[8] + (size_t)3 * FF * D; K = FF; N = D; mode = 0; WT = (bf16*)(C.ws + WS_WOUT + 3 * WOUT_STRIDE); }
        transpose_item(W, K, N, WT, mode, scr, r, C.lane);
    }
}
__device__ __forceinline__ void filler_convert(const Ctx& C, const int begin, const int end, const int nrem) {
    const int c = (int)blockIdx.x;
    if (c >= nrem && C.G > nrem) convert_items(C, begin, end, c - nrem, C.G - nrem);
    else if (C.G <= nrem) convert_items(C, begin, end, c, C.G);
}
__device__ __forceinline__ void p0_prologue(const Ctx& C) {
    const int lane = C.lane;
    convert_items(C, CV_WIN0, CV_WOUT0, (int)blockIdx.x, C.G);
    convert_items(C, CV_P0B_B, CV_P0B_E, (int)blockIdx.x, C.G);
    convert_items(C, CV_P0C_B, CV_P0C_E, (int)blockIdx.x, C.G);
    {
        float* modp = (float*)(C.ws + WS_MODP);
        const float* cvec = C.in[1]; const float* cctx = C.in[3]; const float* adaw = C.in[4];
        for (int it = C.gw; it < 2 * 72 * 16; it += C.NGW) {
            const int l = it / 1152, r = it % 1152, jb = r / 16, ks = r % 16, j0 = jb * 256 + lane * 4, k0 = ks * 128;
            const float sa0 = siluf(cvec[k0 + lane]), sb0 = siluf(cvec[k0 + 64 + lane]);
            const float sa1 = siluf(cvec[D + k0 + lane]), sb1 = siluf(cvec[D + k0 + 64 + lane]);
            const float sa2 = siluf(cctx[k0 + lane]), sb2 = siluf(cctx[k0 + 64 + lane]);
            f32x4 a0 = (f32x4){0.f, 0.f, 0.f, 0.f}, a1 = a0, a2 = a0;
            const float* wp = adaw + ((size_t)l * D + k0) * NMOD + j0;
#pragma unroll 16
            for (int kk = 0; kk < 64; ++kk) { const f32x4 w = __builtin_nontemporal_load((const f32x4*)(wp + (size_t)kk * NMOD));
                const float s0 = __shfl(sa0, kk), s1 = __shfl(sa1, kk), s2 = __shfl(sa2, kk);
                a0 += w * s0; a1 += w * s1; a2 += w * s2; }
#pragma unroll 16
            for (int kk = 0; kk < 64; ++kk) { const f32x4 w = __builtin_nontemporal_load((const f32x4*)(wp + (size_t)(64 + kk) * NMOD));
                const float s0 = __shfl(sb0, kk), s1 = __shfl(sb1, kk), s2 = __shfl(sb2, kk);
                a0 += w * s0; a1 += w * s1; a2 += w * s2; }
            float* m0 = modp + ((size_t)(ks * 2 + l) * 3) * NMOD + j0;
            *(f32x4*)m0 = a0; *(f32x4*)(m0 + NMOD) = a1; *(f32x4*)(m0 + 2 * NMOD) = a2;
        }
    }
    {
        float* rope = (float*)(C.ws + WS_ROPE);
        for (int idx = C.gw * 64 + lane; idx < SEQ * 64; idx += C.NGW * 64) {
            const int t = idx >> 6, a = (idx >> 5) & 1, i = idx & 31;
            const float pos = (float)(a ? (t & 63) : (t >> 6));
            const float invf = powf(10000.0f, -(float)(2 * i) / 64.0f);
            const float ang = pos * invf; float sn, cs; sincosf(ang, &sn, &cs);
            *(float2*)(rope + (size_t)idx * 2) = make_float2(cs, sn);
        }
    }
}

__device__ __forceinline__ float mod_value(const float* modp, const float* adab, int l, int v, int j) {
    float acc = adab[l * NMOD + j]; const size_t i = (size_t)(l * 3 + v) * NMOD + j;
#pragma unroll
    for (int ks = 0; ks < 16; ++ks) acc += modp[(size_t)ks * (2 * 3 * NMOD) + i];
    return acc;
}
__device__ __forceinline__ void tv_build(const Ctx& C) {
    float* TV = (float*)(C.ws + WS_XCTX); const float* modp = (const float*)(C.ws + WS_MODP); const float* adab = C.in[5]; const float* ng = C.in[6];
    for (int e = C.gw * 64 + C.lane; e < 7 * 3 * D; e += C.NGW * 64) {
        const int cfg = e / (3 * D), v = (e / D) % 3, col = e % D;
        const bool has_post = cfg != 0, has_pre = cfg != 6;
        const int lpost = cfg <= 3 ? 0 : 1, k3 = cfg == 0 ? 0 : (cfg - 1) % 3;
        const int gpost = 2 * k3 + 1, igate = 3 * k3 + 2; const float wgt = k3 == 1 ? 1.0f : 0.5f;
        const int lpre = cfg <= 2 ? 0 : 1, p3 = cfg % 3;
        const int gpre = 2 * p3, ishift = 3 * p3, iscale = 3 * p3 + 1;
        float A = 0.f, B = 0.f, Cc = 0.f;
        if (has_post) A = wgt * mod_value(modp, adab, lpost, v, igate * D + col) * ng[(lpost * 6 + gpost) * D + col];
        if (has_pre) { B = ng[(lpre * 6 + gpre) * D + col] * (1.0f + mod_value(modp, adab, lpre, v, iscale * D + col)); Cc = mod_value(modp, adab, lpre, v, ishift * D + col); }
        float* t = TV + ((size_t)(cfg * 3 + v) * 3) * D + col;
        t[0] = A; t[D] = B; t[2 * D] = Cc;
    }
}

__device__ __forceinline__ void thin_phase(const Ctx& C, const int cfg, bool has_post, int lpost, int gpost, int igate, float wgt,
                                           bool has_pre, int lpre, int gpre, int ishift, int iscale,
                                           const int srck, const int dstk, int nrows, int npart) {
    LAS float* vec = (LAS float*)C.lds;
    { const f32x4* tv = (const f32x4*)((const float*)(C.ws + WS_XCTX) + (size_t)cfg * 9 * D);
#pragma unroll
      for (int i = 0; i < 9; ++i) ((LAS f32x4*)vec)[C.tid + 512 * i] = tv[C.tid + 512 * i]; }
    __syncthreads();
    const bf16* OUTB = (const bf16*)(C.ws + WS_OUT); bf16* HB = (bf16*)(C.ws + WS_H); bf16* XBB = (bf16*)(C.ws + WS_XB);
    const int lane = C.lane;
    for (int row = C.gw; row < nrows; row += C.NGW) {
        const bool lat = row < MLAT; const int v = lat ? (row >> 14) : 2;

        const LAS f32x4* vA = (const LAS f32x4*)(vec + (v * 3 + 0) * D) + lane;
        const LAS f32x4* vB = (const LAS f32x4*)(vec + (v * 3 + 1) * D) + lane;
        const LAS f32x4* vC = (const LAS f32x4*)(vec + (v * 3 + 2) * D) + lane;
        f32x4 x[8];
        if (srck == 0) { const float* xs = lat ? C.in[0] + (size_t)row * D : C.in[2] + (size_t)(row - MLAT) * D;
#pragma unroll
            for (int j = 0; j < 8; ++j) x[j] = __builtin_nontemporal_load((const f32x4*)xs + lane + 64 * j); }
        else { const uint2* xp = (const uint2*)(XBB + (size_t)row * D) + lane;
#pragma unroll
            for (int j = 0; j < 8; ++j) { const tu32x2 w = __builtin_nontemporal_load((const tu32x2*)xp + 64 * j); x[j] = (f32x4){bflo(w.x), bfhi(w.x), bflo(w.y), bfhi(w.y)}; } }
        if (has_post) {
            f32x4 o[8]; float ss = 0.f;
            if (lat || npart == 0) { const uint2* op = (const uint2*)(OUTB + (size_t)row * D) + lane;
#pragma unroll
                for (int j = 0; j < 8; ++j) { const tu32x2 w = __builtin_nontemporal_load((const tu32x2*)op + 64 * j); o[j] = (f32x4){bflo(w.x), bfhi(w.x), bflo(w.y), bfhi(w.y)}; } }
            else { const f32x4* pp = (const f32x4*)((const float*)(C.ws + WS_PART) + (size_t)(row - MLAT) * D) + lane;
#pragma unroll
                for (int j = 0; j < 8; ++j) o[j] = pp[64 * j];
#pragma unroll 1
                for (int ks = 1; ks < npart; ++ks) { const f32x4* pk = pp + (size_t)ks * MCTX * D / 4;
#pragma unroll
                    for (int j = 0; j < 8; ++j) o[j] += pk[64 * j]; } }
#pragma unroll
            for (int j = 0; j < 8; ++j) ss += (o[j][0] * o[j][0] + o[j][1] * o[j][1]) + (o[j][2] * o[j][2] + o[j][3] * o[j][3]);
            const float rstd = rsqrtf(wave_sum(ss) * (1.0f / D) + EPSN);
#pragma unroll
            for (int j = 0; j < 8; ++j) x[j] += vA[64 * j] * (o[j] * rstd);
        }
        if (dstk == 1) { uint2* xq = (uint2*)(XBB + (size_t)row * D) + lane;
#pragma unroll
            for (int j = 0; j < 8; ++j) { tu32x2 w; w.x = cvt2bf(x[j][0], x[j][1]); w.y = cvt2bf(x[j][2], x[j][3]); __builtin_nontemporal_store(w, (tu32x2*)xq + 64 * j); } }
        if (dstk == 2) { float* xd = C.out + (size_t)row * D;
#pragma unroll
            for (int j = 0; j < 8; ++j) __builtin_nontemporal_store(x[j], (f32x4*)xd + lane + 64 * j); }
        if (has_pre) {
            float ss = 0.f;
#pragma unroll
            for (int j = 0; j < 8; ++j) ss += (x[j][0] * x[j][0] + x[j][1] * x[j][1]) + (x[j][2] * x[j][2] + x[j][3] * x[j][3]);
            const float rstd = rsqrtf(wave_sum(ss) * (1.0f / D) + EPSN);
            uint2* hp = (uint2*)(HB + (size_t)row * D) + lane;
#pragma unroll
            for (int j = 0; j < 8; ++j) { const f32x4 h = (x[j] * rstd) * vB[64 * j] + vC[64 * j]; uint2 w; w.x = cvt2bf(h[0], h[1]); w.y = cvt2bf(h[2], h[3]); hp[64 * j] = w; }
        }
    }
    __syncthreads();
}

typedef float f32x16 __attribute__((ext_vector_type(16)));
typedef unsigned u32x4 __attribute__((ext_vector_type(4)));
typedef short s16x4 __attribute__((ext_vector_type(4)));
typedef short v4i16_t __attribute__((ext_vector_type(4)));
typedef float f32x2_t __attribute__((ext_vector_type(2))); typedef __bf16 bf16x2_t __attribute__((ext_vector_type(2)));
__device__ __forceinline__ unsigned cvtpk_s(float lo, float hi) { f32x2_t v = {lo, hi}; bf16x2_t b = __builtin_convertvector(v, bf16x2_t); return __builtin_bit_cast(unsigned, b); }
__device__ __forceinline__ unsigned off_a(unsigned row, unsigned ch) { return 2048u * (row >> 3) + 512u * (ch >> 2) + 64u * (row & 7) + 16u * ((ch & 3) ^ ((row >> 2) & 3)); }
__device__ __forceinline__ s16x4 vtr(LAS const unsigned char* p) { return __builtin_bit_cast(s16x4, __builtin_amdgcn_ds_read_tr16_b64_v4i16((LAS v4i16_t*)p)); }

template <int OFF> __device__ __forceinline__ void vrd8(unsigned alo, unsigned ahi, s16x4 (&v)[8]) {
    asm volatile("ds_read_b64_tr_b16 %0, %8 offset:%10\n\tds_read_b64_tr_b16 %1, %9 offset:%10\n\t"
                 "ds_read_b64_tr_b16 %2, %8 offset:%11\n\tds_read_b64_tr_b16 %3, %9 offset:%11\n\t"
                 "ds_read_b64_tr_b16 %4, %8 offset:%12\n\tds_read_b64_tr_b16 %5, %9 offset:%12\n\t"
                 "ds_read_b64_tr_b16 %6, %8 offset:%13\n\tds_read_b64_tr_b16 %7, %9 offset:%13"
                 : "=&v"(v[0]), "=&v"(v[1]), "=&v"(v[2]), "=&v"(v[3]), "=&v"(v[4]), "=&v"(v[5]), "=&v"(v[6]), "=&v"(v[7])
                 : "v"(alo), "v"(ahi), "n"(OFF), "n"(OFF + 512), "n"(OFF + 1024), "n"(OFF + 1536) : "memory");
}
template <int N> __device__ __forceinline__ void vwait8(s16x4 (&v)[8]) {
    asm volatile("s_waitcnt lgkmcnt(%8)" : "+v"(v[0]), "+v"(v[1]), "+v"(v[2]), "+v"(v[3]), "+v"(v[4]), "+v"(v[5]), "+v"(v[6]), "+v"(v[7]) : "n"(N) : "memory");
}
template <int OFF> __device__ __forceinline__ void krd4(unsigned ke, unsigned ko, u32x4 (&a)[4]) {
    asm volatile("ds_read_b128 %0, %4 offset:%6\n\tds_read_b128 %1, %4 offset:%7\n\tds_read_b128 %2, %5 offset:%6\n\tds_read_b128 %3, %5 offset:%7"
                 : "=&v"(a[0]), "=&v"(a[1]), "=&v"(a[2]), "=&v"(a[3]) : "v"(ke), "v"(ko), "n"(OFF), "n"(OFF + 8192) : "memory");
}
template <int N> __device__ __forceinline__ void kwait4(u32x4 (&a)[4]) {
    asm volatile("s_waitcnt lgkmcnt(%4)" : "+v"(a[0]), "+v"(a[1]), "+v"(a[2]), "+v"(a[3]) : "n"(N) : "memory");
}

__device__ __forceinline__ void attn_mfma(const Ctx& C, const bf16* Q, const bf16* Kb, const bf16* Vb, const float* sink, bf16* O, bool with_ctx) {
    const int lane = C.lane, w = C.wave, r = lane & 31, h = lane >> 5, tid = C.tid;
    LAS unsigned char* lds = C.lds;
    const int vcu = (C.G % 8 == 0) ? ((int)blockIdx.x % 8) * (C.G / 8) + (int)blockIdx.x / 8 : (int)blockIdx.x;
    const int NU = 2048 + (with_ctx ? 32 : 0);
    const int drow = 8 * w + ((lane >> 2) & 7), dch0 = 4 * (lane >> 5) + ((lane & 3) ^ ((drow >> 2) & 3));
    const unsigned blk = (lane >> 4) & 1, tq = (lane & 15) >> 2, tp = lane & 3;
    const unsigned ke0 = (unsigned)(size_t)lds + 2048u * (r >> 3) + 64u * (r & 7) + 16u * ((unsigned)h ^ ((r >> 2) & 3));
    const unsigned ko0 = (unsigned)(size_t)lds + 2048u * (r >> 3) + 64u * (r & 7) + 16u * ((unsigned)(2 + h) ^ ((r >> 2) & 3));
    const unsigned vlo0 = (unsigned)(size_t)lds + 64u * (4 * h + tq) + 16u * ((2 * blk + (tp >> 1)) ^ (unsigned)h) + 8u * (tp & 1);
    const unsigned vhi0 = (unsigned)(size_t)lds + 2048u + 64u * (4 * h + tq) + 16u * ((2 * blk + (tp >> 1)) ^ (unsigned)(h + 2)) + 8u * (tp & 1);
    const int sinkv = __builtin_bit_cast(int, sink[lane & 15] * 1.4426950408889634f);
    const int qs = (w < 4) ? (w & 3) : 3 - (w & 3);
    const bool late = w >= 4;
    int ksl = 0, vsl = 0;
    for (int u = vcu; u < NU; u += C.G) {
        int b, n, hk, gp; const bool isctx = u >= 2048;
        if (!isctx) { gp = u & 1; hk = (u >> 1) & 3; n = (u >> 3) & 127; b = u >> 10; }
        else { const int v = u - 2048; gp = v & 1; hk = (v >> 1) & 3; n = (v >> 3) & 1; b = v >> 4; }
        const int hd = hk * 4 + gp * 2 + (w >> 2);
        const int qrow0 = isctx ? MLAT + b * CTXL + n * 128 : b * SEQ + n * 128;
        const int qi = 32 * qs + r;
        bf16x8 qf[8];
        f32x16 Oacc[4];
#pragma unroll
        for (int dt = 0; dt < 4; ++dt)
#pragma unroll
            for (int i = 0; i < 16; ++i) Oacc[dt][i] = 0.f;
        float m = __builtin_bit_cast(float, __builtin_amdgcn_readlane(sinkv, __builtin_amdgcn_readfirstlane(hd))), l = h == 0 ? 1.0f : 0.0f;
        int ti = isctx ? 6 : (n == 0 ? 2 : 0);
#define ATT_TILE_ROW(t_) ((t_) < 6 ? (size_t)b * SEQ + (size_t)(n - 1 + ((t_) >> 1)) * 128 + ((t_) & 1) * 64 : (size_t)MLAT + b * CTXL + ((t_) - 6) * 64)
#define ATT_DMA(src_, t_, dstoff_) do { const unsigned char* g_ = (const unsigned char*)((src_) + (ATT_TILE_ROW(t_) + drow) * KVD + hk * 128) + dch0 * 16; \
            __builtin_amdgcn_global_load_lds((const unsigned*)g_, (LAS unsigned*)(lds + (dstoff_) + 2048 * w), 16, 0, 0); \
            __builtin_amdgcn_global_load_lds((const unsigned*)(g_ + 128), (LAS unsigned*)(lds + (dstoff_) + 2048 * w + 1024), 16, 0, 0); } while (0)
#define ATT_DMAKV(t_, ks_, vs_) do { ATT_DMA(Kb, t_, (ks_) * 16384); ATT_DMA(Vb, t_, 49152 + (vs_) * 16384); } while (0)
#define ATT_NEXT(t_) (((t_) + 1 == 4 && !isctx && n == 127) ? 6 : (t_) + 1)
        ATT_DMAKV(ti, ksl, vsl);
        { const u32x4* qp = (const u32x4*)(Q + (size_t)(qrow0 + qi) * D + hd * 128);
#pragma unroll
          for (int s = 0; s < 8; ++s) qf[s] = __builtin_bit_cast(bf16x8, __builtin_nontemporal_load(qp + 2 * s + h)); }
        asm volatile("" : "+v"(qf[0]), "+v"(qf[1]), "+v"(qf[2]), "+v"(qf[3]), "+v"(qf[4]), "+v"(qf[5]), "+v"(qf[6]), "+v"(qf[7]));
        ATT_DMAKV(ATT_NEXT(ti), (ksl == 2 ? 0 : ksl + 1), ((vsl + 1) & 3));
        asm volatile("s_waitcnt vmcnt(4)" ::: "memory");
        asm volatile("s_waitcnt lgkmcnt(0)\n\ts_barrier" ::: "memory");
        bool pend = false; unsigned palo = 0, pahi = 0; u32x4 pw[4];
#define ATT_PVG(g_) do { vwait8<((g_) < 3 ? 8 : 0)>(vv[(g_) & 1]); const bf16x8 pb = __builtin_bit_cast(bf16x8, pw[g_]); \
                    _Pragma("unroll") for (int dt = 0; dt < 4; ++dt) { \
                        const s16x4 lo = vv[(g_) & 1][2 * dt], hi = vv[(g_) & 1][2 * dt + 1]; \
                        const bf16x8 va = (bf16x8){lo[0], lo[1], lo[2], lo[3], hi[0], hi[1], hi[2], hi[3]}; \
                        Oacc[dt] = __builtin_amdgcn_mfma_f32_32x32x16_bf16(va, pb, Oacc[dt], 0, 0, 0); } \
                    if ((g_) < 2) vrd8<49152 + 4096 * ((g_) + 2 < 3 ? (g_) + 2 : 3)>(palo, pahi, vv[(g_) & 1]);        \
                    __builtin_amdgcn_sched_barrier(0); } while (0)
#define ATT_PVALL() do { s16x4 vv[2][8]; vrd8<49152>(palo, pahi, vv[0]); vrd8<49152 + 4096>(palo, pahi, vv[1]); ATT_PVG(0); ATT_PVG(1); ATT_PVG(2); ATT_PVG(3); } while (0)
        for (;;) {
            const int tn = ATT_NEXT(ti); const bool more = tn < 10;
            const int tnn = ATT_NEXT(tn); const bool more2 = more && tnn < 10;
            const int kn = ksl == 2 ? 0 : ksl + 1, kw = kn == 2 ? 0 : kn + 1, vn = (vsl + 1) & 3, vw = (vsl + 2) & 3;
            if (more2) ATT_DMAKV(tnn, kw, vw);
            if (pend) { ATT_PVALL(); pend = false; }
            const int mtp = (ti < 6) ? (ti >> 1) : 1;
            const int kbase = (ti & 1) * 64;
            const bool skip = (mtp == 0 && kbase + 63 < 32 * qs) || (mtp == 2 && kbase > 32 * qs + 31);
            const bool needmask = (mtp == 0 && kbase < 32 * qs + 31) || (mtp == 2 && kbase + 63 > 32 * qs);
            if (!skip) {
                f32x16 S0, S1;
#pragma unroll
                for (int i = 0; i < 16; ++i) { S0[i] = 0.f; S1[i] = 0.f; }
                { u32x4 ka[4][4];
                  const unsigned ke = ke0 + ksl * 16384, ko = ko0 + ksl * 16384;
                  krd4<0>(ke, ko, ka[0]); krd4<512>(ke, ko, ka[1]); krd4<1024>(ke, ko, ka[2]); krd4<1536>(ke, ko, ka[3]);
#define ATT_QK(j_, n_) do { kwait4<n_>(ka[j_]); \
                      S0 = __builtin_amdgcn_mfma_f32_32x32x16_bf16(__builtin_bit_cast(bf16x8, ka[j_][0]), qf[2 * (j_)], S0, 0, 0, 0); \
                      S1 = __builtin_amdgcn_mfma_f32_32x32x16_bf16(__builtin_bit_cast(bf16x8, ka[j_][1]), qf[2 * (j_)], S1, 0, 0, 0); \
                      S0 = __builtin_amdgcn_mfma_f32_32x32x16_bf16(__builtin_bit_cast(bf16x8, ka[j_][2]), qf[2 * (j_) + 1], S0, 0, 0, 0); \
                      S1 = __builtin_amdgcn_mfma_f32_32x32x16_bf16(__builtin_bit_cast(bf16x8, ka[j_][3]), qf[2 * (j_) + 1], S1, 0, 0, 0); \
                      __builtin_amdgcn_sched_barrier(0); } while (0)
                  ATT_QK(0, 12); ATT_QK(1, 8); ATT_QK(2, 4); ATT_QK(3, 0);
#undef ATT_QK
                }
                if (needmask) {
                    const int thr = qi - kbase - 4 * h;
                    if (mtp == 0) {
#pragma unroll
                        for (int i = 0; i < 16; ++i) { const int c = (i & 3) + 8 * (i >> 2); if (c < thr) S0[i] = -__builtin_inff(); if (c + 32 < thr) S1[i] = -__builtin_inff(); }
                    } else {
#pragma unroll
                        for (int i = 0; i < 16; ++i) { const int c = (i & 3) + 8 * (i >> 2); if (c > thr) S0[i] = -__builtin_inff(); if (c + 32 > thr) S1[i] = -__builtin_inff(); }
                    }
                }
                float mx = fmaxf(S0[0], S1[0]);
#pragma unroll
                for (int i = 1; i < 16; ++i) mx = fmaxf(mx, fmaxf(S0[i], S1[i]));
                mx = fmaxf(mx, __shfl_xor(mx, 32));
                if (__any(mx > m + 8.0f)) {
                    const float mn = fmaxf(m, mx), alpha = __builtin_amdgcn_exp2f(m - mn); m = mn; l *= alpha;
#pragma unroll
                    for (int dt = 0; dt < 4; ++dt)
#pragma unroll
                        for (int i = 0; i < 16; ++i) Oacc[dt][i] *= alpha;
                }
                float rs = 0.f;
#pragma unroll
                for (int i = 0; i < 16; ++i) { S0[i] = __builtin_amdgcn_exp2f(S0[i] - m); S1[i] = __builtin_amdgcn_exp2f(S1[i] - m); rs += S0[i] + S1[i]; }
                l += rs;
#pragma unroll
                for (int s2 = 0; s2 < 2; ++s2) {
                    pw[s2].x = cvtpk_s(S0[8 * s2 + 0], S0[8 * s2 + 1]); pw[s2].y = cvtpk_s(S0[8 * s2 + 2], S0[8 * s2 + 3]); pw[s2].z = cvtpk_s(S0[8 * s2 + 4], S0[8 * s2 + 5]); pw[s2].w = cvtpk_s(S0[8 * s2 + 6], S0[8 * s2 + 7]);
                    pw[2 + s2].x = cvtpk_s(S1[8 * s2 + 0], S1[8 * s2 + 1]); pw[2 + s2].y = cvtpk_s(S1[8 * s2 + 2], S1[8 * s2 + 3]); pw[2 + s2].z = cvtpk_s(S1[8 * s2 + 4], S1[8 * s2 + 5]); pw[2 + s2].w = cvtpk_s(S1[8 * s2 + 6], S1[8 * s2 + 7]); }
                palo = vlo0 + vsl * 16384; pahi = vhi0 + vsl * 16384;
                if (late) pend = true; else ATT_PVALL();
            }
            if (more2) { asm volatile("s_waitcnt vmcnt(4)" ::: "memory"); } else { asm volatile("s_waitcnt vmcnt(0)" ::: "memory"); }
            asm volatile("s_waitcnt lgkmcnt(0)\n\ts_barrier" ::: "memory");
            if (!more) { ksl = kn; vsl = vn; break; }
            ti = tn; ksl = kn; vsl = vn;
        }
        if (pend) ATT_PVALL();
#undef ATT_PVG
#undef ATT_PVALL
        const float lt = l + __shfl_xor(l, 32), inv = 1.0f / lt;
        bf16* orow = O + (size_t)(qrow0 + qi) * D + hd * 128 + (h ? 8 : 0);
#pragma unroll
        for (int dt = 0; dt < 4; ++dt)
#pragma unroll
            for (int gp2 = 0; gp2 < 2; ++gp2) {
                unsigned ax = cvtpk_s(Oacc[dt][8 * gp2 + 0] * inv, Oacc[dt][8 * gp2 + 1] * inv), ay = cvtpk_s(Oacc[dt][8 * gp2 + 2] * inv, Oacc[dt][8 * gp2 + 3] * inv);
                unsigned bx = cvtpk_s(Oacc[dt][8 * gp2 + 4] * inv, Oacc[dt][8 * gp2 + 5] * inv), by = cvtpk_s(Oacc[dt][8 * gp2 + 6] * inv, Oacc[dt][8 * gp2 + 7] * inv);
                const auto rx = __builtin_amdgcn_permlane32_swap(ax, bx, false, false); const auto ry = __builtin_amdgcn_permlane32_swap(ay, by, false, false);
                u32x4 wv; wv.x = rx[0]; wv.y = ry[0]; wv.z = rx[1]; wv.w = ry[1];
                *(u32x4*)(orow + 32 * dt + 16 * gp2) = wv; }
#undef ATT_TILE_ROW
#undef ATT_DMA
#undef ATT_DMAKV
#undef ATT_NEXT
    }
}

__device__ __forceinline__ float gelu_tanh(float x) { const float z2 = 1.5957691216057308f * (x + 0.044715f * x * x * x); return x * __builtin_amdgcn_rcpf(1.0f + __expf(-z2)); }

constexpr int TOKS = CTXL + SEQ;
constexpr int NCHK = 130;
constexpr int SS_KT = 131072, SS_KTD = 4608, SS_ST = SS_KT + 2 * SS_KTD;
constexpr int ST_F = 1152, ST_A16 = 1280, ST_A32 = 1408, ST_A64 = 1536, ST_A128 = 1664;
__device__ __forceinline__ unsigned swzb(unsigned row, unsigned chunk) { return row * 256u + ((chunk ^ (row & 15u)) << 4); }
template <int CTRL> __device__ __forceinline__ float dppf(float v) { return __int_as_float(__builtin_amdgcn_update_dpp(0, __float_as_int(v), CTRL, 0xf, 0xf, true)); }
template <int CTRL> __device__ __forceinline__ float dppfo(float o, float v) { return __int_as_float(__builtin_amdgcn_update_dpp(__float_as_int(o), __float_as_int(v), CTRL, 0xf, 0xf, false)); }
template <int CTRL> __device__ __forceinline__ f32x4 dpp4o(const f32x4 o, const f32x4 v) { return (f32x4){dppfo<CTRL>(o[0], v[0]), dppfo<CTRL>(o[1], v[1]), dppfo<CTRL>(o[2], v[2]), dppfo<CTRL>(o[3], v[3])}; }
template <int CTRL> __device__ __forceinline__ f32x4 dpp4(const f32x4 v) { return (f32x4){dppf<CTRL>(v[0]), dppf<CTRL>(v[1]), dppf<CTRL>(v[2]), dppf<CTRL>(v[3])}; }
__device__ __forceinline__ f32x4 cmul2(const f32x4 m, const f32x4 x) { return (f32x4){m[0] * x[0] - m[1] * x[1], m[0] * x[1] + m[1] * x[0], m[2] * x[2] - m[3] * x[3], m[2] * x[3] + m[3] * x[2]}; }
__device__ __forceinline__ f32x4 cfma2(const f32x4 m, const f32x4 x, const f32x4 s) {
    f32x2_t s0 = {s[0], s[1]}, s1 = {s[2], s[3]};
    const f32x2_t m0 = {m[0], m[1]}, m1 = {m[2], m[3]}, x0 = {x[0], x[1]}, x1 = {x[2], x[3]};
    asm("v_pk_fma_f32 %0, %1, %2, %0 op_sel_hi:[0,1,1]\n\tv_pk_fma_f32 %0, %1, %2, %0 op_sel:[1,1,0] op_sel_hi:[1,0,1] neg_lo:[1,0,0]" : "+v"(s0) : "v"(m0), "v"(x0));
    asm("v_pk_fma_f32 %0, %1, %2, %0 op_sel_hi:[0,1,1]\n\tv_pk_fma_f32 %0, %1, %2, %0 op_sel:[1,1,0] op_sel_hi:[1,0,1] neg_lo:[1,0,0]" : "+v"(s1) : "v"(m1), "v"(x1));
    return (f32x4){s0[0], s0[1], s1[0], s1[1]};
}
#define MFMA16(a, b, c) __builtin_amdgcn_mfma_f32_16x16x32_bf16((a), (b), (c), 0, 0, 0)

__device__ __forceinline__ void ssm_load_u(const int d, const int k, const bf16* Ugbg, const int lane_in, bf16x8 (&uf)[4]) {
    int lane = lane_in; asm volatile("" : "+v"(lane));
    const int n = lane & 15, q = lane >> 4;
    const int pb = k < 2 ? 0 : CTXL, pl = k < 2 ? CTXL : SEQ, kk = k < 2 ? k : k - 2;
#pragma unroll
    for (int ks = 0; ks < 4; ++ks) { const int idx = kk * 128 + n * 8 + 2 * ks + (q >> 1); const int tok = pb + (d ? pl - 1 - idx : idx);
        uf[ks] = *(const bf16x8*)(Ugbg + (size_t)tok * 16 + 8 * (q & 1)); }
}
template <int MODE> __device__ __forceinline__ void ssm_chunk(LAS const unsigned char* lds, const int d, const bf16x8 (&uf)[4], f32x4 (&hc)[8], const float* Hnext, float* Ek, f32x4 (&acc)[8], const int lane_in) {
    int lane = lane_in; asm volatile("" : "+v"(lane));
    const int n = lane & 15, q = lane >> 4;
    LAS const unsigned char* Pt = lds + d * 65536; LAS const unsigned char* Rt = Pt + 32768;
    LAS const unsigned char* Kt = lds + SS_KT + d * SS_KTD; LAS const float* ST = (LAS const float*)(lds + SS_ST + d * 7168);
    f32x4 S[8];
    { bf16x8 pa[2][8];
#pragma unroll
      for (int j = 0; j < 8; ++j) pa[0][j] = *(LAS const bf16x8*)(Pt + swzb(16 * (j >> 2) + n, 4 * (j & 3) + q));
#pragma unroll
      for (int mb = 0; mb < 4; ++mb) {
          if (mb < 3) {
#pragma unroll
              for (int j = 0; j < 8; ++j) pa[(mb + 1) & 1][j] = *(LAS const bf16x8*)(Pt + swzb(16 * (2 * mb + 2 + (j >> 2)) + n, 4 * (j & 3) + q)); }
#pragma unroll
          for (int j = 0; j < 8; ++j) { const int m = 2 * mb + (j >> 2); if ((j & 3) == 0) S[m] = (f32x4){0.f, 0.f, 0.f, 0.f}; S[m] = MFMA16(pa[mb & 1][j], uf[j & 3], S[m]); }
          __builtin_amdgcn_sched_barrier(0); } }
    f32x4 mmv[8];
#pragma unroll
    for (int m = 0; m < 8; ++m) mmv[m] = *(LAS const f32x4*)(ST + 8 * 128 + (8 * m + 2 * q) * 2);
    if (MODE == 1) {
        { const float z = n == 0 ? 1.0f : 0.0f;
#pragma unroll
          for (int m = 0; m < 8; ++m) S[m] = cfma2(mmv[m], hc[m] * z, S[m]); }
        __builtin_amdgcn_sched_barrier(0);
    }
#pragma unroll
    for (int m = 0; m < 8; ++m) S[m] = cfma2(mmv[m], dpp4<0x111>(S[m]), S[m]);
    __builtin_amdgcn_sched_barrier(0);
#pragma unroll
    for (int m = 0; m < 8; ++m) mmv[m] = *(LAS const f32x4*)(ST + ST_A16 + (8 * m + 2 * q) * 2);
#pragma unroll
    for (int m = 0; m < 8; ++m) S[m] = cfma2(mmv[m], dpp4<0x112>(S[m]), S[m]);
    __builtin_amdgcn_sched_barrier(0);
#pragma unroll
    for (int m = 0; m < 8; ++m) mmv[m] = *(LAS const f32x4*)(ST + ST_A32 + (8 * m + 2 * q) * 2);
#pragma unroll
    for (int m = 0; m < 8; ++m) S[m] = cfma2(mmv[m], dpp4<0x114>(S[m]), S[m]);
    __builtin_amdgcn_sched_barrier(0);
#pragma unroll
    for (int m = 0; m < 8; ++m) mmv[m] = *(LAS const f32x4*)(ST + ST_A64 + (8 * m + 2 * q) * 2);
#pragma unroll
    for (int m = 0; m < 8; ++m) S[m] = cfma2(mmv[m], dpp4<0x118>(S[m]), S[m]);
    __builtin_amdgcn_sched_barrier(0);
    if (MODE == 0) {
        if (n == 15) {
#pragma unroll
            for (int m = 0; m < 8; ++m) *(f32x4*)(Ek + (8 * m + 2 * q) * 2) = S[m]; }
        return;
    }
    bf16x8 hb[4];
#pragma unroll
    for (int ks2 = 0; ks2 < 4; ++ks2) {
        const f32x4 h0 = dpp4o<0x111>(hc[2 * ks2], S[2 * ks2]), h1 = dpp4o<0x111>(hc[2 * ks2 + 1], S[2 * ks2 + 1]);
        u32x4 w; w.x = cvtpk_s(h0[0], h0[1]); w.y = cvtpk_s(h0[2], h0[3]); w.z = cvtpk_s(h1[0], h1[1]); w.w = cvtpk_s(h1[2], h1[3]);
        hb[ks2] = __builtin_bit_cast(bf16x8, w);
    }
    __builtin_amdgcn_sched_barrier(0);
#pragma unroll
    for (int m = 0; m < 8; ++m) hc[m] = *(const f32x4*)(Hnext + (8 * m + 2 * q) * 2);
    __builtin_amdgcn_sched_barrier(0);
    u32x4 ra[2][4], kq[2][4];
#define SSM_LOADT(t_, b_) do { _Pragma("unroll") for (int ks2 = 0; ks2 < 4; ++ks2) ra[b_][ks2] = *(LAS const u32x4*)(Rt + swzb(16 * (t_) + n, 4 * ks2 + q)); \
        _Pragma("unroll") for (int ks = 0; ks <= (t_) / 2; ++ks) kq[b_][ks] = *(LAS const u32x4*)(Kt + ((t_) - 2 * ks - (q >> 1) + 1) * 512 + n * 32 + (q & 1) * 16); } while (0)
    SSM_LOADT(0, 0);
#pragma unroll
    for (int t = 0; t < 8; ++t) {
        if (t < 7) SSM_LOADT(t + 1, (t + 1) & 1);
#pragma unroll
        for (int ks2 = 0; ks2 < 4; ++ks2) acc[t] = MFMA16(__builtin_bit_cast(bf16x8, ra[t & 1][ks2]), hb[ks2], acc[t]);
#pragma unroll
        for (int ks = 0; ks <= t / 2; ++ks) acc[t] = MFMA16(__builtin_bit_cast(bf16x8, kq[t & 1][ks]), uf[ks], acc[t]);
        __builtin_amdgcn_sched_barrier(0);
    }
#undef SSM_LOADT
}

__device__ __forceinline__ void ssm_phase(const Ctx& C, const bf16* Ug, float* EH, bf16* Gout) {
    const int tid_in = C.tid, tid = C.tid, lane = C.lane, w = C.wave;
    LAS unsigned char* lds = C.lds;
    const float* a_re = C.in[13]; const float* a_im = C.in[14]; const float* log_dt = C.in[15];
    const float* b_re = C.in[16]; const float* b_im = C.in[17]; const float* c_re = C.in[18]; const float* c_im = C.in[19]; const float* dskip = C.in[20];
    for (int unit = (int)blockIdx.x; unit < 256; unit += C.G) {
        const int xx = unit & 7, yy = unit >> 3, zz = xx * 8 + (yy >> 2), b = zz >> 5, g = (zz & 31) * 4 + (yy & 3);
        LAS unsigned char* stg = lds + 65536 + 32768;
        { f32x4 tmp[4]; int tid = tid_in; asm volatile("" : "+v"(tid));
#pragma unroll
          for (int i = 0; i < 4; ++i) { const int idx = tid + 512 * i, a_ = idx >> 8, off = idx & 255, dg_ = (a_ >> 2) * 128 + g, k_ = a_ & 3;
              const float* src = (k_ == 0 ? b_re : k_ == 1 ? b_im : k_ == 2 ? c_re : c_im) + (size_t)dg_ * 1024;
              tmp[i] = *(const f32x4*)(src + off * 4); }
#pragma unroll
          for (int i = 0; i < 4; ++i) { const int idx = tid + 512 * i; *(LAS f32x4*)(stg + (idx >> 8) * 4096 + (idx & 255) * 16) = tmp[i]; } }
        if (tid < 128) { const int d = tid >> 6, p = tid & 63, dg = d * 128 + g;
            LAS float* ST = (LAS float*)(lds + SS_ST + d * 7168);
            const double are = (double)a_re[dg * 64 + p], aim = (double)a_im[dg * 64 + p], dt = (double)expf(log_dt[dg]);
            const double mg = exp(are * dt); double sn, cs; sincos(aim * dt, &sn, &cs); const double ar1 = mg * cs, ai1 = mg * sn;
            { const double xr = ar1 - 1.0, xi = ai1, den = are * are + aim * aim;
              ST[ST_F + p * 2] = (float)((xr * are + xi * aim) / den); ST[ST_F + p * 2 + 1] = (float)((xi * are - xr * aim) / den); }
            double pr = 1.0, pi = 0.0;
#pragma unroll 1
            for (int j = 0; j <= 8; ++j) { ST[(j * 64 + p) * 2] = (float)pr; ST[(j * 64 + p) * 2 + 1] = (float)pi; const double nr = pr * ar1 - pi * ai1, ni = pr * ai1 + pi * ar1; pr = nr; pi = ni; }
            double qr = ar1, qi = ai1;
#pragma unroll 1
            for (int sq = 0; sq < 3; ++sq) { const double nr = qr * qr - qi * qi, ni = 2.0 * qr * qi; qr = nr; qi = ni; }
#pragma unroll 1
            for (int jj = 0; jj < 4; ++jj) { const double nr = qr * qr - qi * qi, ni = 2.0 * qr * qi; qr = nr; qi = ni;
                ST[ST_A16 + jj * 128 + p * 2] = (float)qr; ST[ST_A16 + jj * 128 + p * 2 + 1] = (float)qi; }
        }
        __syncthreads();
#pragma unroll 1
        for (int d = 0; d < 2; ++d) {
            int tid = tid_in; asm volatile("" : "+v"(tid));
            LAS const float* ST = (LAS const float*)(lds + SS_ST + d * 7168);
            LAS const float* Sbr = (LAS const float*)(stg + d * 16384); LAS const float* Sbi = Sbr + 1024; LAS const float* Scr = Sbr + 2048; LAS const float* Sci = Sbr + 3072;
            LAS unsigned char* Pt = lds + d * 65536; LAS unsigned char* Kt = lds + SS_KT + d * SS_KTD;
            {
              const int col = tid & 127, row0 = tid >> 7, s_ = col >> 4, cp = col & 15, comp = row0 & 1;
#pragma unroll 8
              for (int i = 0; i < 32; ++i) { const int row = row0 + 4 * i, p = row >> 1;
                  const float br = Sbr[p * 16 + cp], bi = Sbi[p * 16 + cp];
                  const float fr = ST[ST_F + p * 2], fi = ST[ST_F + p * 2 + 1], bbr = fr * br - fi * bi, bbi = fr * bi + fi * br;
                  const float ar = ST[((7 - s_) * 64 + p) * 2], ai = ST[((7 - s_) * 64 + p) * 2 + 1];
                  const float v = comp ? ar * bbi + ai * bbr : ar * bbr - ai * bbi;
                  *(LAS bf16*)(Pt + swzb(row, col >> 3) + (col & 7) * 2) = (bf16)f2bf(v); } }
            {
              const int c = (tid >> 4) & 15, cp = tid & 15, lag0 = tid >> 8; float sum[4] = {0.f, 0.f, 0.f, 0.f};
#pragma unroll 8
              for (int p = 0; p < 64; ++p) {
                  const float br = Sbr[p * 16 + cp], bi = Sbi[p * 16 + cp];
                  const float cr = Scr[c * 64 + p], ci = Sci[c * 64 + p];
                  const float fr = ST[ST_F + p * 2], fi = ST[ST_F + p * 2 + 1], bbr = fr * br - fi * bi, bbi = fr * bi + fi * br;
                  const float wr = cr * bbr - ci * bbi, wi = cr * bbi + ci * bbr;
#pragma unroll
                  for (int i = 0; i < 4; ++i) { const int lag = lag0 + 2 * i; const float ar = ST[(lag * 64 + p) * 2], ai = ST[(lag * 64 + p) * 2 + 1]; sum[i] += wr * ar - wi * ai; } }
#pragma unroll
              for (int i = 0; i < 4; ++i) *(LAS bf16*)(Kt + (1 + lag0 + 2 * i) * 512 + c * 32 + cp * 2) = (bf16)f2bf(sum[i]);
              if (tid < 128) ((LAS unsigned*)Kt)[tid] = 0u; }
        }
#pragma unroll 1
        for (int d = 0; d < 2; ++d) {
            int tid = tid_in; asm volatile("" : "+v"(tid));
            LAS const float* ST = (LAS const float*)(lds + SS_ST + d * 7168);
            LAS const float* Scr = (LAS const float*)(stg + d * 16384) + 2048; LAS const float* Sci = Scr + 1024;
            LAS unsigned char* Rt = lds + d * 65536 + 32768;
            {
              const int col = tid & 127, ks2 = col >> 5, kpos = col & 31;
              const int pp = 32 * ks2 + 16 * ((kpos >> 2) & 1) + 4 * (kpos >> 3) + (kpos & 3), p = pp >> 1, comp = pp & 1;
              float cr[4], ci[4];
#pragma unroll
              for (int j = 0; j < 4; ++j) { const int c = (tid >> 7) + 4 * j; cr[j] = Scr[c * 64 + p]; ci[j] = Sci[c * 64 + p]; }
              asm volatile("" : "+v"(cr[0]), "+v"(cr[1]), "+v"(cr[2]), "+v"(cr[3]), "+v"(ci[0]), "+v"(ci[1]), "+v"(ci[2]), "+v"(ci[3]));
              __syncthreads();
#pragma unroll
              for (int t = 0; t < 8; ++t) { const float ar = ST[((t + 1) * 64 + p) * 2], ai = ST[((t + 1) * 64 + p) * 2 + 1];
#pragma unroll
                  for (int j = 0; j < 4; ++j) { const int row = t * 16 + (tid >> 7) + 4 * j;
                      const float v = comp ? -(cr[j] * ai + ci[j] * ar) : cr[j] * ar - ci[j] * ai;
                      *(LAS bf16*)(Rt + swzb(row, col >> 3) + (col & 7) * 2) = (bf16)f2bf(v); } } }
        }
        __syncthreads();
        const bf16* Ugbg = Ug + (size_t)(b * 128 + g) * TOKS * 16;
        float* Eb = EH + (size_t)unit * (4 * NCHK * 128); float* Hb = Eb + 2 * NCHK * 128;
        { f32x4 dummy[8]; bf16x8 ufa[4], ufb[4];
          ssm_load_u(w >= NCHK ? 1 : 0, w >= NCHK ? w - NCHK : w, Ugbg, lane, ufa);
#pragma unroll 1
          for (int cd = w; cd < 2 * NCHK; cd += 2 * NWAVES) {
              const int cd1 = cd + NWAVES, cd2 = cd + 2 * NWAVES;
              { const int c1 = cd1 < 2 * NCHK ? cd1 : cd; const int d1 = c1 >= NCHK ? 1 : 0; ssm_load_u(d1, c1 - d1 * NCHK, Ugbg, lane, ufb); }
              { const int d = cd >= NCHK ? 1 : 0, k = cd - d * NCHK; ssm_chunk<0>(lds, d, ufa, dummy, nullptr, Eb + (size_t)(d * NCHK + k) * 128, dummy, lane); }
              { const int c2 = cd2 < 2 * NCHK ? cd2 : cd; const int d2 = c2 >= NCHK ? 1 : 0; ssm_load_u(d2, c2 - d2 * NCHK, Ugbg, lane, ufa); }
              if (cd1 < 2 * NCHK) { const int d = cd1 >= NCHK ? 1 : 0, k = cd1 - d * NCHK; ssm_chunk<0>(lds, d, ufb, dummy, nullptr, Eb + (size_t)(d * NCHK + k) * 128, dummy, lane); }
          } }
        __syncthreads();
        if (tid < 128) { const int d = tid >> 6, p = tid & 63; LAS const float* ST = (LAS const float*)(lds + SS_ST + d * 7168);
            const float ar = ST[ST_A128 + p * 2], ai = ST[ST_A128 + p * 2 + 1]; float hr = 0.f, hi = 0.f;
            const float2* Ep = (const float2*)(Eb + (size_t)d * NCHK * 128) + p; float2* Hp = (float2*)(Hb + (size_t)d * NCHK * 128) + p;
#pragma unroll 1
            for (int k0 = 0; k0 < NCHK; k0 += 26) { float2 e[26];
#pragma unroll
                for (int j = 0; j < 26; ++j) e[j] = Ep[(size_t)(k0 + j) * 64];
#pragma unroll
                for (int j = 0; j < 26; ++j) { Hp[(size_t)(k0 + j) * 64] = make_float2(hr, hi); const float nr = ar * hr - ai * hi + e[j].x, ni = ar * hi + ai * hr + e[j].y; hr = nr; hi = ni; } }
        }
        __syncthreads();
        { bf16x8 ufa[4], ufb[4]; f32x4 hcs[8];
          ssm_load_u(0, 2 + w, Ugbg, lane, ufa);
          { int l0 = lane; asm volatile("" : "+v"(l0)); const int q0 = l0 >> 4;
#pragma unroll
            for (int m = 0; m < 8; ++m) hcs[m] = *(const f32x4*)(Hb + (size_t)(2 + w) * 128 + (8 * m + 2 * q0) * 2); }
#pragma unroll 1
          for (int kk = w; kk < 128; kk += NWAVES) {
              int ln = lane; asm volatile("" : "+v"(ln));
              const int n = ln & 15, q = ln >> 4;
              const f32x4 dsk = *(const f32x4*)(dskip + g * 16 + 4 * q);
              f32x4 accf[8], accb[8];
#pragma unroll
              for (int t = 0; t < 8; ++t) { accf[t] = (f32x4){0.f, 0.f, 0.f, 0.f}; accb[t] = (f32x4){0.f, 0.f, 0.f, 0.f}; }
              ssm_load_u(1, 2 + 127 - kk, Ugbg, lane, ufb);
              ssm_chunk<1>(lds, 0, ufa, hcs, Hb + (size_t)(NCHK + 2 + 127 - kk) * 128, nullptr, accf, lane);
              { const int kn = kk + NWAVES < 128 ? kk + NWAVES : kk; ssm_load_u(0, 2 + kn, Ugbg, lane, ufa); }
              uint2 uwv[8];
#pragma unroll
              for (int t = 0; t < 8; ++t) uwv[t] = *(const uint2*)(Ugbg + (size_t)(CTXL + kk * 128 + n * 8 + t) * 16 + 4 * q);
              ssm_chunk<1>(lds, 1, ufb, hcs, Hb + (size_t)(2 + (kk + NWAVES < 128 ? kk + NWAVES : kk)) * 128, nullptr, accb, lane);
#pragma unroll
              for (int tp2 = 0; tp2 < 4; ++tp2) {
                  unsigned gx[2], gy[2];
#pragma unroll
                  for (int tt = 0; tt < 2; ++tt) { const int t = 2 * tp2 + tt;
                      const f32x4 yb = dpp4<0x140>(accb[7 - t]);
                      const uint2 uw = uwv[t];
                      const f32x4 u = (f32x4){bflo(uw.x), bfhi(uw.x), bflo(uw.y), bfhi(uw.y)};
                      const f32x4 y = accf[t] + yb + dsk * u;
                      gx[tt] = cvtpk_s(gelu_tanh(y[0]), gelu_tanh(y[1])); gy[tt] = cvtpk_s(gelu_tanh(y[2]), gelu_tanh(y[3])); }
                  const auto sx = __builtin_amdgcn_permlane16_swap(gx[0], gx[1], false, false); const auto sy = __builtin_amdgcn_permlane16_swap(gy[0], gy[1], false, false);
                  u32x4 gw; gw.x = sx[0]; gw.y = sy[0]; gw.z = sx[1]; gw.w = sy[1];
                  const int tls = kk * 128 + n * 8 + 2 * tp2 + (q & 1);
                  *(u32x4*)(Gout + ((size_t)b * SEQ + tls) * D + g * 16 + 4 * (q & ~1)) = gw; }
          } }
        __syncthreads();
    }
}

constexpr int NPHASE = 22;
#ifndef MK_ONE_LAUNCH
#define MK_ONE_LAUNCH 1
#endif
__global__ void __launch_bounds__(NWAVES * 64, 2) fwd_kernel(Args args) {
    extern __shared__ __attribute__((aligned(16))) unsigned char lds_raw[];
    Ctx C;
    C.lds = (LAS unsigned char*)lds_raw;
    C.tid = threadIdx.x; C.lane = C.tid & 63; C.wave = __builtin_amdgcn_readfirstlane(C.tid >> 6);
    C.G = gridDim.x; C.gw = (int)blockIdx.x * NWAVES + C.wave; C.NGW = C.G * NWAVES;
    C.in = args.in; C.out = args.out; C.ws = args.ws;
    volatile LAS unsigned* MISC = (volatile LAS unsigned*)(C.lds + MISC_OFF);
    if (C.tid < 64) ((LAS unsigned*)(C.lds + MISC_OFF))[C.tid] = 0u;
    __syncthreads();
    XcdBarrier bar; bar.bar = (unsigned*)(C.ws + WS_CTL) + CW_BAR; bar.x = 0; bar.st = nullptr;
    if (MK_ONE_LAUNCH) bar = xcd_barrier_post((unsigned*)(C.ws + WS_CTL) + CW_BAR, MISC + 8);
    const int lo = args.ph_lo, hi = args.ph_hi;
#define IN(k) (lo <= (k) && (k) < hi)
#define SEAM(k) do { if (IN(k) && IN((k) + 1)) xcd_barrier(bar); } while (0)
    unsigned char* ws = C.ws;
    bf16* HB = (bf16*)(ws + WS_H); bf16* OUTB = (bf16*)(ws + WS_OUT); bf16* ACTB = (bf16*)(ws + WS_ACT);
    bf16* QB = (bf16*)(ws + WS_Q); bf16* KB = (bf16*)(ws + WS_K); bf16* VB = (bf16*)(ws + WS_V); bf16* UB = (bf16*)(ws + WS_U);
    float* YB = (float*)(ws + WS_Y); float* XCTX = (float*)(ws + WS_XCTX); float* PARTB = (float*)(ws + WS_PART);
    const float* x_in = C.in[0]; const float* ctx_in = C.in[2];
#define WIN(i) ((const bf16*)(ws + WS_WIN + (size_t)(i) * WIN_STRIDE))
#define WOUT(i) ((const bf16*)(ws + WS_WOUT + (size_t)(i) * WOUT_STRIDE))
#define GEMM_PHASE(EPI_T, EPI, Aptr, Btptr, M_, N_, K_) GEMM_PHASE_W(EPI_T, EPI, Aptr, Btptr, M_, N_, K_, 8)
#define GEMM_PHASE_W(EPI_T, EPI, Aptr, Btptr, M_, N_, K_, WGM_) do { pg8::Gemm g_{(Aptr), (Btptr), (M_), (N_), (K_), (K_), 0}; pg8::StaticOrder S_; S_.init((M_), (N_), C.G, (int)blockIdx.x, (WGM_) & 15, (WGM_) >> 4); \
        pg8::gemm_phase<EPI_T, pg8::StaticOrder, true, true>(C.lds, g_, S_, (EPI)); } while (0)

#define GEMM_CTX_SPLITK(Aptr, Btptr, N_, K_, NKS_) do { pg8::Gemm g_{(Aptr), (Btptr), MALL, (N_), (K_) / (NKS_), (K_), (K_) / (NKS_)}; pg8::SplitKOrder S_; S_.init(MLAT / 256, MCTX / 256, (N_), (NKS_), C.G, (int)blockIdx.x); \
        pg8::EpiPartial E_{PARTB, (N_), MLAT, (size_t)MCTX * (N_)}; pg8::gemm_phase<pg8::EpiPartial, pg8::SplitKOrder, true, true>(C.lds, g_, S_, E_); } while (0)
    if (IN(0)) { p0_prologue(C); } SEAM(0);
    if (IN(1)) { tv_build(C); xcd_barrier(bar); thin_phase(C, 0, false, 0, 0, 0, 0.f, true, 0, 0, 0, 1, 0, 0, MALL, 0); } SEAM(1);
    if (IN(2)) { pg8::EpiGated<0> E{ACTB, FF}; GEMM_PHASE(pg8::EpiGated<0>, E, HB, WIN(0), MALL, 2 * FF, D); filler_convert(C, CV_S2_B, CV_S2_E, (MALL / 256) * (2 * FF / 256) % 256); } SEAM(2);
    if (IN(3)) { pg8::EpiPlain E{OUTB, D}; GEMM_PHASE_W(pg8::EpiPlain, E, ACTB, WOUT(0), MLAT, D, FF, 4 + 16); GEMM_CTX_SPLITK(ACTB, WOUT(0), D, FF, 11); } SEAM(3);
    if (IN(4)) { thin_phase(C, 1, true, 0, 1, 2, 0.5f, true, 0, 2, 3, 4, 0, 1, MALL, 11); } SEAM(4);
    if (IN(5)) { pg8::EpiQKV E{QB, KB, VB, (const float*)(ws + WS_ROPE), 0.08838834764831845f * 1.4426950408889634f}; GEMM_PHASE(pg8::EpiQKV, E, HB, (const bf16*)(ws + WS_WQKV), MALL, 3072, D); filler_convert(C, CV_S5_B, CV_S5_E, (MALL / 256) * (3072 / 256) % 256); } SEAM(5);
    if (IN(6)) { attn_mfma(C, QB, KB, VB, C.in[11], HB, true); } SEAM(6);
    if (IN(7)) { pg8::EpiPlain E{OUTB, D}; GEMM_PHASE(pg8::EpiPlain, E, HB, (const bf16*)(ws + WS_WO), MLAT, D, D); GEMM_CTX_SPLITK(HB, (const bf16*)(ws + WS_WO), D, D, 4); } SEAM(7);
    if (IN(8)) { thin_phase(C, 2, true, 0, 3, 5, 1.0f, true, 0, 4, 6, 7, 1, 1, MALL, 4); } SEAM(8);
    if (IN(9)) { pg8::EpiGated<0> E{ACTB, FF}; GEMM_PHASE(pg8::EpiGated<0>, E, HB, WIN(1), MALL, 2 * FF, D); filler_convert(C, CV_S9_B, CV_S9_E, (MALL / 256) * (2 * FF / 256) % 256); } SEAM(9);
    if (IN(10)) { pg8::EpiPlain E{OUTB, D}; GEMM_PHASE_W(pg8::EpiPlain, E, ACTB, WOUT(1), MLAT, D, FF, 4 + 16); GEMM_CTX_SPLITK(ACTB, WOUT(1), D, FF, 11); } SEAM(10);
    if (IN(11)) { thin_phase(C, 3, true, 0, 5, 8, 0.5f, true, 1, 0, 0, 1, 1, 1, MALL, 11); } SEAM(11);
    if (IN(12)) { pg8::EpiGated<0> E{ACTB, FF}; GEMM_PHASE(pg8::EpiGated<0>, E, HB, WIN(2), MALL, 2 * FF, D); filler_convert(C, CV_S12_B, CV_S12_E, (MALL / 256) * (2 * FF / 256) % 256); } SEAM(12);
    if (IN(13)) { pg8::EpiPlain E{OUTB, D}; GEMM_PHASE_W(pg8::EpiPlain, E, ACTB, WOUT(2), MLAT, D, FF, 4 + 16); GEMM_CTX_SPLITK(ACTB, WOUT(2), D, FF, 11); } SEAM(13);
    if (IN(14)) { thin_phase(C, 4, true, 1, 1, 2, 0.5f, true, 1, 2, 3, 4, 1, 1, MALL, 11); } SEAM(14);
    if (IN(15)) { pg8::EpiUg E{UB}; GEMM_PHASE(pg8::EpiUg, E, HB, (const bf16*)(ws + WS_WSIN), MALL, D, D); filler_convert(C, CV_S15_B, CV_S15_E, (MALL / 256) * (D / 256) % 256); } SEAM(15);
    if (IN(16)) { ssm_phase(C, UB, YB, HB); } SEAM(16);
    if (IN(17)) { pg8::EpiGated<1> E{OUTB, D}; GEMM_PHASE(pg8::EpiGated<1>, E, HB, (const bf16*)(ws + WS_WGLU), MLAT, 4096, D); } SEAM(17);
    if (IN(18)) { thin_phase(C, 5, true, 1, 3, 5, 1.0f, true, 1, 4, 6, 7, 1, 1, MLAT, 0); } SEAM(18);
    if (IN(19)) { pg8::EpiGated<0> E{ACTB, FF}; GEMM_PHASE(pg8::EpiGated<0>, E, HB, WIN(3), MLAT, 2 * FF, D); } SEAM(19);
    if (IN(20)) { pg8::EpiPlain E{OUTB, D}; GEMM_PHASE_W(pg8::EpiPlain, E, ACTB, WOUT(3), MLAT, D, FF, 4 + 16); } SEAM(20);
    if (IN(21)) { thin_phase(C, 6, true, 1, 5, 8, 0.5f, false, 0, 0, 0, 0, 1, 2, MLAT, 0); }
#undef IN
#undef SEAM
}

extern "C" void kernel_launch(void* const* d_in, const int* in_sizes, int n_in, void* d_out, int out_size, void* d_ws, size_t ws_size, hipStream_t stream) {
    static int grid = 0;
    if (grid == 0) {
        if (n_in != 22 || out_size != MLAT * D || ws_size < WS_END) { fprintf(stderr, "kernel_launch: unexpected shapes (n_in %d, out %d, ws %zu)\n", n_in, out_size, ws_size); grid = -1; return; }
        int dev = 0, cus = 0, per_cu = 0;
        if (hipGetDevice(&dev) != hipSuccess || hipDeviceGetAttribute(&cus, hipDeviceAttributeMultiprocessorCount, dev) != hipSuccess) { grid = -1; return; }
        if (hipFuncSetAttribute((const void*)fwd_kernel, hipFuncAttributeMaxDynamicSharedMemorySize, LDS_BYTES) != hipSuccess) { fprintf(stderr, "kernel_launch: hipFuncSetAttribute failed\n"); grid = -1; return; }
        if (hipOccupancyMaxActiveBlocksPerMultiprocessor(&per_cu, (const void*)fwd_kernel, NWAVES * 64, LDS_BYTES) != hipSuccess || per_cu < 1) fprintf(stderr, "kernel_launch: occupancy query says %d\n", per_cu);
        (void)hipGetLastError();
        grid = cus;
    }
    if (grid < 0) return;
    (void)hipMemsetAsync((char*)d_ws + WS_CTL, 0, CTL_ZERO_BYTES, stream);
    Args a{};
    for (int i = 0; i < 22; ++i) a.in[i] = (const float*)d_in[i];
    a.out = (float*)d_out; a.ws = (unsigned char*)d_ws;
#if MK_ONE_LAUNCH
    a.ph_lo = 0; a.ph_hi = NPHASE;
    hipLaunchKernelGGL(fwd_kernel, dim3(grid), dim3(NWAVES * 64), LDS_BYTES, stream, a);
#else
    for (int p = 0; p < NPHASE; ++p) { a.ph_lo = p; a.ph_hi = p + 1; hipLaunchKernelGGL(fwd_kernel, dim3(grid), dim3(NWAVES * 64), LDS_BYTES, stream, a); }
#endif
}
```

```cpp
#include <hip/hip_runtime.h>
#include <cstdio>
#include <cstdint>
namespace pg8 {
#define PG8_LAS __attribute__((address_space(3)))
typedef unsigned short bf16_t;
typedef short bf16x8 __attribute__((ext_vector_type(8)));
typedef float f32x4 __attribute__((ext_vector_type(4)));
typedef unsigned u32x4 __attribute__((ext_vector_type(4)));
constexpr int BM = 256, BK = 64, HALF = 128, HTB = HALF * BK * 2  , STAGE_BYTES = 8 * HTB, NXCD = 8, WGM = 8;

__host__ __device__ __forceinline__ int lds_byte(int r, int c) { const int st = (r >> 4) * 2 + (c >> 5), rr = r & 15, cc = c & 31, ob = rr * 64 + cc * 2; return st * 1024 + (ob ^ (((ob >> 9) & 1) << 5)); }
__host__ __device__ __forceinline__ void stage_rc(int b, int& R, int& C) { const int st = b / 1024, sb = b % 1024, swz = sb ^ (((sb >> 9) & 1) << 5); R = (st >> 1) * 16 + swz / 64; C = (st & 1) * 32 + (swz % 64) / 2; }
__host__ __device__ __forceinline__ int perm32(int rho) { const int n = rho >> 4, i = rho & 15; return 8 * (i >> 2) + 4 * n + (i & 3); }

struct Unit { int pm, pn, ks; };
struct Gemm { const bf16_t* A; const bf16_t* Bt; int M, N, K, ld, kchunk; };

struct StaticOrder {
    int nM, nN, nwg, G, c, wgm, rev;
    __host__ __device__ void init(int M, int N, int G_, int c_, int wgm_ = WGM, int rev_ = 0) { nM = M / BM; nN = N / BM; nwg = nM * nN; G = G_; c = c_; wgm = wgm_; rev = rev_; }
    __host__ __device__ bool next(int i, Unit& u) const {
        const long L = (long)i * G + c; if (L >= nwg) return false;
        const int nMa = (nM / (wgm * NXCD)) * (wgm * NXCD), nwga = nMa * nN;
        if (nMa > 0 && nMa < nM) {
            if (L >= nwga) { const int e = (int)L - nwga, nMr = nM - nMa; u.pm = nMa + e % nMr; u.pn = e / nMr; u.ks = 0; return true; }
            int wgid = (int)L; { const int q = nwga / NXCD, xcd = wgid % NXCD; int off = wgid / NXCD; if (rev) off = q - 1 - off; wgid = xcd * q + off; }
            const int nig = wgm * nN, gid = wgid / nig, fm = gid * wgm;
            u.pm = fm + ((wgid % nig) % wgm); u.pn = (wgid % nig) / wgm; u.ks = 0; return true;
        }
        int wgid = (int)L; { const int q = nwg / NXCD, r = nwg % NXCD, xcd = wgid % NXCD; int off = wgid / NXCD; if (rev) off = (xcd < r ? q + 1 : q) - 1 - off; wgid = (xcd < r ? xcd * (q + 1) : r * (q + 1) + (xcd - r) * q) + off; }
        const int nig = wgm * nN, gid = wgid / nig, fm = gid * wgm, gsz = (nM - fm) < wgm ? (nM - fm) : wgm;
        u.pm = fm + ((wgid % nig) % gsz); u.pn = (wgid % nig) / gsz; u.ks = 0; return true;
    }
    __device__ __forceinline__ void a_ready(const Unit&) const {}
    __device__ __forceinline__ void done(const Unit&) const {}
};

struct SplitKOrder {
    int pm0, npm, nN, nks, G, c;
    __host__ __device__ void init(int pm0_, int npm_, int N, int nks_, int G_, int c_) { pm0 = pm0_; npm = npm_; nN = N / BM; nks = nks_; G = G_; c = c_; }
    __host__ __device__ bool next(int i, Unit& u) const {
        const int L = i * G + c; if (L >= npm * nN * nks) return false;
        u.ks = L % nks; const int t = L / nks; u.pn = t % nN; u.pm = pm0 + t / nN; return true;
    }
    __device__ __forceinline__ void a_ready(const Unit&) const {}
    __device__ __forceinline__ void done(const Unit&) const {}
};

__device__ __forceinline__ unsigned cvt_pk_bf16(float lo, float hi) { unsigned r; asm volatile("v_cvt_pk_bf16_f32 %0, %1, %2" : "=v"(r) : "v"(lo), "v"(hi)); return r; }

template <class Epi, class Sched, bool ALIGN_EPI = false, bool SP2 = false>
__device__ __forceinline__ void gemm_phase(PG8_LAS unsigned char* lds, const Gemm g, const Sched& S, const Epi& E) {
    const int tid = threadIdx.x, wid = __builtin_amdgcn_readfirstlane(tid >> 6), lane = tid & 63, wr = wid >> 2, wc = wid & 3, fr = lane & 15, fq = lane >> 4;
    const int K = g.ld, nt = g.K / BK; const size_t kcb = (size_t)g.kchunk * 2;
    unsigned voffA[2], voffB[2];
#pragma unroll
    for (int i = 0; i < 2; ++i) { int R, C; stage_rc(tid * 16 + i * 8192, R, C); const int Rb = Epi::PERM ? ((R & ~31) + perm32(R & 31)) : R;
        voffA[i] = (unsigned)(R * K + C) * 2u; voffB[i] = (unsigned)(Rb * K + C) * 2u; }
    const size_t kstep = (size_t)(BK * 2);
    const size_t hstep = (size_t)HALF * K * 2;
    const size_t tstep = 2 * hstep;
    const unsigned ldsw = (unsigned)wid * 1024u;
    const int aoff = lds_byte(wr * 64 + fr, fq * 8), boff = lds_byte(wc * 32 + fr, fq * 8);
#define PG8_SA(b, h) (((b) * 2 + (h)) * HTB)
#define PG8_SB(b, h) ((4 + (b) * 2 + (h)) * HTB)
#define PG8_STAGE(bufoff, gbase, voff) do { _Pragma("unroll") for (int _i = 0; _i < 2; ++_i) \
        __builtin_amdgcn_global_load_lds((const unsigned*)((const char*)(gbase) + (voff)[_i]), (PG8_LAS unsigned*)(lds + (bufoff) + ldsw + _i * 8192), 16, 0, 0); } while (0)
#define PG8_LDA(dst, b, h) do { _Pragma("unroll") for (int m = 0; m < 4; ++m) _Pragma("unroll") for (int k = 0; k < 2; ++k) dst[m][k] = *(const PG8_LAS bf16x8*)(lds + PG8_SA(b, h) + aoff + m * 2048 + k * 1024); } while (0)
#define PG8_LDB(dst, b, h) do { _Pragma("unroll") for (int n = 0; n < 2; ++n) _Pragma("unroll") for (int k = 0; k < 2; ++k) dst[n][k] = *(const PG8_LAS bf16x8*)(lds + PG8_SB(b, h) + boff + n * 2048 + k * 1024); } while (0)
#define PG8_MMA(ai, bj, At, Bt) do { __builtin_amdgcn_s_setprio(1); _Pragma("unroll") for (int m = 0; m < 4; ++m) _Pragma("unroll") for (int n = 0; n < 2; ++n) _Pragma("unroll") for (int k = 0; k < 2; ++k) \
        acc[ai][bj][m][n] = __builtin_amdgcn_mfma_f32_16x16x32_bf16(Bt[n][k], At[m][k], acc[ai][bj][m][n], 0, 0, 0); __builtin_amdgcn_s_setprio(0); } while (0)
#define PG8_WAIT_V(n) asm volatile("s_waitcnt vmcnt(" #n ")" ::: "memory")
#define PG8_WAIT_L(n) asm volatile("s_waitcnt lgkmcnt(" #n ")" ::: "memory")
#define PG8_BAR __builtin_amdgcn_s_barrier()
#define PG8_SCHED __builtin_amdgcn_sched_barrier(0)
    Unit cur, nxt; int ui = 0;
    if (!S.next(0, cur)) return;
    f32x4 acc[2][2][4][2];
#pragma unroll
    for (int a = 0; a < 2; ++a)
#pragma unroll
        for (int b = 0; b < 2; ++b)
#pragma unroll
            for (int m = 0; m < 4; ++m)
#pragma unroll
                for (int n = 0; n < 2; ++n) acc[a][b][m][n] = (f32x4){0.f, 0.f, 0.f, 0.f};
    bf16x8 At[4][2], B0[2][2], B1[2][2];
    const char* cA = (const char*)g.A + (size_t)cur.pm * tstep + (size_t)cur.ks * kcb; const char* cB = (const char*)g.Bt + (size_t)cur.pn * tstep + (size_t)cur.ks * kcb;
    S.a_ready(cur);
    if constexpr (SP2) {
        PG8_STAGE(PG8_SB(0, 0), cB, voffB); PG8_STAGE(PG8_SB(0, 1), cB + hstep, voffB); PG8_STAGE(PG8_SA(0, 0), cA, voffA); PG8_STAGE(PG8_SA(0, 1), cA + hstep, voffA);
        if (wr == 1) PG8_BAR;
        PG8_WAIT_V(2); PG8_BAR;
        PG8_STAGE(PG8_SB(1, 0), cB + kstep, voffB); PG8_STAGE(PG8_SA(1, 0), cA + kstep, voffA); PG8_STAGE(PG8_SB(1, 1), cB + hstep + kstep, voffB);
        PG8_WAIT_V(6); PG8_BAR;
    } else {
        PG8_STAGE(PG8_SB(0, 0), cB, voffB); PG8_STAGE(PG8_SA(0, 0), cA, voffA); PG8_STAGE(PG8_SB(0, 1), cB + hstep, voffB); PG8_STAGE(PG8_SA(0, 1), cA + hstep, voffA);
        if (wr == 1) PG8_BAR;
        PG8_WAIT_V(4); PG8_BAR;
        PG8_STAGE(PG8_SB(1, 0), cB + kstep, voffB); PG8_STAGE(PG8_SA(1, 0), cA + kstep, voffA); PG8_STAGE(PG8_SB(1, 1), cB + hstep + kstep, voffB);
        PG8_WAIT_V(6); PG8_BAR;
    }
    for (;;) {
        const bool has_next = S.next(ui + 1, nxt);
        const char* nA = has_next ? (const char*)g.A + (size_t)nxt.pm * tstep + (size_t)nxt.ks * kcb : cA; const char* nB = has_next ? (const char*)g.Bt + (size_t)nxt.pn * tstep + (size_t)nxt.ks * kcb : cB;
        for (int t = 0; t < nt; t += 2) {
            const bool last = (t == nt - 2);
            const char* a1 = cA + (size_t)(t + 1) * kstep;
            const char* a2 = last ? nA : cA + (size_t)(t + 2) * kstep; const char* b2 = last ? nB : cB + (size_t)(t + 2) * kstep;
            const char* a3 = a2 + kstep; const char* b3 = b2 + kstep;
            if (last && has_next) S.a_ready(nxt);
            if constexpr (SP2) {
            PG8_LDB(B0, 0, 0); PG8_LDB(B1, 0, 1); PG8_SCHED; PG8_LDA(At, 0, 0); PG8_STAGE(PG8_SA(1, 1), a1 + hstep, voffA);
            PG8_WAIT_V(8); PG8_WAIT_L(0); PG8_BAR; PG8_MMA(0, 0, At, B0); PG8_MMA(0, 1, At, B1); PG8_BAR; PG8_SCHED;
            PG8_LDA(At, 0, 1); PG8_STAGE(PG8_SB(0, 0), b2, voffB); PG8_STAGE(PG8_SB(0, 1), b2 + hstep, voffB); PG8_STAGE(PG8_SA(0, 0), a2, voffA);
            PG8_WAIT_V(8); PG8_WAIT_L(0); PG8_BAR; PG8_MMA(1, 0, At, B0); PG8_MMA(1, 1, At, B1); PG8_BAR; PG8_SCHED;
            PG8_LDB(B0, 1, 0); PG8_LDB(B1, 1, 1); PG8_SCHED; PG8_LDA(At, 1, 0); PG8_STAGE(PG8_SA(0, 1), a2 + hstep, voffA);
            PG8_WAIT_V(8); PG8_WAIT_L(0); PG8_BAR; PG8_MMA(0, 0, At, B0); PG8_MMA(0, 1, At, B1); PG8_BAR; PG8_SCHED;
            PG8_LDA(At, 1, 1); PG8_STAGE(PG8_SB(1, 0), b3, voffB); PG8_STAGE(PG8_SB(1, 1), b3 + hstep, voffB); PG8_STAGE(PG8_SA(1, 0), a3, voffA);
            PG8_WAIT_V(8); PG8_WAIT_L(0); PG8_BAR; PG8_MMA(1, 0, At, B0); PG8_MMA(1, 1, At, B1); PG8_BAR; PG8_SCHED;
            } else {
            PG8_LDB(B0, 0, 0); PG8_SCHED; PG8_LDA(At, 0, 0); PG8_STAGE(PG8_SA(1, 1), a1 + hstep, voffA);
            PG8_WAIT_L(8); PG8_BAR; PG8_WAIT_L(0); PG8_MMA(0, 0, At, B0); PG8_BAR; PG8_SCHED;
            PG8_LDB(B1, 0, 1); PG8_STAGE(PG8_SB(0, 0), b2, voffB);
            PG8_BAR; PG8_WAIT_L(0); PG8_MMA(0, 1, At, B1); PG8_BAR;
            PG8_LDA(At, 0, 1); PG8_STAGE(PG8_SA(0, 0), a2, voffA);
            PG8_BAR; PG8_WAIT_L(0); PG8_MMA(1, 0, At, B0); PG8_BAR; PG8_SCHED;
            PG8_STAGE(PG8_SB(0, 1), b2 + hstep, voffB);
            PG8_WAIT_V(6); PG8_BAR; PG8_MMA(1, 1, At, B1); PG8_BAR;
            PG8_LDB(B0, 1, 0); PG8_SCHED; PG8_LDA(At, 1, 0); PG8_STAGE(PG8_SA(0, 1), a2 + hstep, voffA);
            PG8_WAIT_L(8); PG8_BAR; PG8_WAIT_L(0); PG8_MMA(0, 0, At, B0); PG8_BAR; PG8_SCHED;
            PG8_LDB(B1, 1, 1); PG8_STAGE(PG8_SB(1, 0), b3, voffB);
            PG8_BAR; PG8_WAIT_L(0); PG8_MMA(0, 1, At, B1); PG8_BAR;
            PG8_LDA(At, 1, 1); PG8_STAGE(PG8_SA(1, 0), a3, voffA);
            PG8_BAR; PG8_WAIT_L(0); PG8_MMA(1, 0, At, B0); PG8_BAR; PG8_SCHED;
            PG8_STAGE(PG8_SB(1, 1), b3 + hstep, voffB);
            PG8_WAIT_V(6); PG8_BAR; PG8_MMA(1, 1, At, B1); PG8_BAR;
            }
        }
        if constexpr (ALIGN_EPI) { if (wr == 0) PG8_BAR; }
        if constexpr (!Epi::AFTER_DRAIN) { E(acc, cur, wr, wc, fr, fq); S.done(cur); }
        if (!has_next) break;
#pragma unroll
        for (int a = 0; a < 2; ++a)
#pragma unroll
            for (int b = 0; b < 2; ++b)
#pragma unroll
                for (int m = 0; m < 4; ++m)
#pragma unroll
                    for (int n = 0; n < 2; ++n) acc[a][b][m][n] = (f32x4){0.f, 0.f, 0.f, 0.f};
        cur = nxt; cA = nA; cB = nB; ++ui;
        if constexpr (ALIGN_EPI) { if (wr == 1) PG8_BAR; }
    }
    PG8_WAIT_V(0);
    if constexpr (!ALIGN_EPI) { if (wr == 0) PG8_BAR; }
    PG8_BAR;
    if constexpr (Epi::AFTER_DRAIN) { E.fused(acc, cur, wr, wc, fr, fq, lds, wid, lane); S.done(cur); }
#undef PG8_SA
#undef PG8_SB
#undef PG8_STAGE
#undef PG8_LDA
#undef PG8_LDB
#undef PG8_MMA
#undef PG8_WAIT_V
#undef PG8_WAIT_L
#undef PG8_BAR
#undef PG8_SCHED
}
}
#define GAS __attribute__((address_space(1)))
#define LAS __attribute__((address_space(3)))
typedef unsigned short bf16;
typedef unsigned v4u __attribute__((ext_vector_type(4)));
typedef float f32x4 __attribute__((ext_vector_type(4)));
typedef short bf16x8 __attribute__((ext_vector_type(8)));
typedef GAS unsigned gu32;
typedef GAS unsigned long long gu64;
#define RLX_AGENT __ATOMIC_RELAXED, __HIP_MEMORY_SCOPE_AGENT
#define LDS_WAIT() asm volatile("s_waitcnt lgkmcnt(0)" ::: "memory")
#define VM_WAIT() asm volatile("s_waitcnt vmcnt(0)" ::: "memory")
__device__ __forceinline__ unsigned long long rt() { return __builtin_amdgcn_s_memrealtime(); }
__device__ __forceinline__ unsigned f2bf(float f) { unsigned u = __builtin_bit_cast(unsigned, f); return (u + 0x7fffu + ((u >> 16) & 1u)) >> 16; }
__device__ __forceinline__ unsigned pk2(float lo, float hi) { return f2bf(lo) | (f2bf(hi) << 16); }

#define XB_TMO      128
#define XB_XCNT(j)  (256  + 64 * (j))
#define XB_XSUB(j)  (1280 + 64 * (j))
#define XB_XGEN(j)  (2304 + 64 * (j))
#define XB_TOP      3328
#define XB_TOPGEN   3392
#define XCD_BAR_WORDS 3456
#define XB_SPIN_CAP (1u << 18)

__device__ __forceinline__ unsigned xb_ld(unsigned* p)              { return __hip_atomic_load(p, __ATOMIC_RELAXED, __HIP_MEMORY_SCOPE_AGENT); }
__device__ __forceinline__ unsigned xb_add(unsigned* p, unsigned v) { return __hip_atomic_fetch_add(p, v, __ATOMIC_RELAXED, __HIP_MEMORY_SCOPE_AGENT); }
__device__ __forceinline__ unsigned xb_xcc_id() { return (unsigned)__builtin_amdgcn_s_getreg((3 << 11) | 20) & 0xFu; }
#define XB_SPIN(cond, bar) do { unsigned _sp = 0; while (cond) { __builtin_amdgcn_s_sleep(1); \
    if ((++_sp & 255u) == 0u) { if (xb_ld(&(bar)[XB_TMO])) break; if (_sp > XB_SPIN_CAP) { atomicAdd(&(bar)[XB_TMO], 1u); break; } } } } while (0)

struct XcdBarrier {
    unsigned* bar; unsigned x;
    volatile LAS unsigned* st;
};

__device__ __forceinline__ XcdBarrier xcd_barrier_post(unsigned* bar, volatile LAS unsigned* st) {
    XcdBarrier b; b.bar = bar; b.x = xb_xcc_id(); b.st = st;
    if (threadIdx.x == 0) (void)xb_add(&bar[XB_XCNT(b.x)], 1u);
    return b;
}
__device__ __forceinline__ void xcd_barrier_complete(unsigned* bar, unsigned x, unsigned& nloc, unsigned& nx) {
    const unsigned G = gridDim.x * gridDim.y * gridDim.z;
    unsigned sum, cnt, mine, sp = 0u;
    for (;;) {
        sum = 0u; cnt = 0u; mine = 0u;
#pragma unroll
        for (unsigned j = 0; j < 16; ++j) { const unsigned c = xb_ld(&bar[XB_XCNT(j)]); sum += c; cnt += (c > 0u) ? 1u : 0u; mine = (j == x) ? c : mine; }
        if (sum == G) break;
        __builtin_amdgcn_s_sleep(1);
        if ((++sp & 255u) == 0u) { if (xb_ld(&bar[XB_TMO])) break; if (sp > XB_SPIN_CAP) { atomicAdd(&bar[XB_TMO], 1u); break; } }
    }
    nloc = mine > 0u ? mine : 1u; nx = cnt > 0u ? cnt : 1u;
}

__device__ __forceinline__ void xcd_barrier(const XcdBarrier& b) {
    asm volatile("s_waitcnt vmcnt(0)" ::: "memory");
    __syncthreads();
    if (threadIdx.x == 0) {
        unsigned* bar = b.bar;
        __builtin_amdgcn_s_waitcnt(0);
        unsigned nloc = b.st[0], nx = b.st[1];
        if (nloc == 0u) { xcd_barrier_complete(bar, b.x, nloc, nx); b.st[0] = nloc; b.st[1] = nx; }
        const unsigned old = xb_add(&bar[XB_XSUB(b.x)], 1u);
        const unsigned gen = old / nloc;
        if (old + 1u == (gen + 1u) * nloc) {
            __builtin_amdgcn_fence(__ATOMIC_RELEASE, "agent");
            asm volatile("s_waitcnt vmcnt(0)" ::: "memory");
            const unsigned og = xb_add(&bar[XB_TOP], 1u);
            const unsigned tg = og / nx;
            if (og + 1u == (tg + 1u) * nx) xb_add(&bar[XB_TOPGEN], 1u);
            else XB_SPIN(xb_ld(&bar[XB_TOPGEN]) == tg, bar);
            __builtin_amdgcn_fence(__ATOMIC_ACQUIRE, "agent");
            xb_add(&bar[XB_XGEN(b.x)], 1u);
            asm volatile("s_waitcnt vmcnt(0)" ::: "memory");
        } else {
            XB_SPIN(xb_ld(&bar[XB_XGEN(b.x)]) == gen, bar);
            __builtin_amdgcn_fence(__ATOMIC_ACQUIRE, "agent");
            asm volatile("s_waitcnt vmcnt(0)" ::: "memory");
        }
    }
    __syncthreads();
}

constexpr int D = 2048, SEQ = 16384, NB = 2, CTXL = 256, FF = 5632;
constexpr int MLAT = NB * SEQ;
constexpr int MCTX = NB * CTXL;
constexpr int MALL = MLAT + MCTX;
constexpr int NMOD = 9 * D;
constexpr int KVD = 512;
constexpr float EPSN = 1e-6f;
constexpr int NWAVES = 8;

constexpr size_t MiB = 1u << 20;
constexpr size_t WS_CTL = 0, CTL_ZERO_BYTES = 2 * MiB;
constexpr size_t WS_MODS = 1 * MiB;
constexpr size_t WS_ROPE = 2 * MiB;
constexpr size_t WS_XCTX = 10 * MiB;
constexpr size_t WS_WIN = 16 * MiB, WIN_STRIDE = 44 * MiB;
constexpr size_t WS_WOUT = 192 * MiB, WOUT_STRIDE = 22 * MiB;
constexpr size_t WS_WQKV = 280 * MiB, WS_WO = 292 * MiB, WS_WSIN = 300 * MiB, WS_WGLU = 308 * MiB;
constexpr size_t WS_H = 324 * MiB;
constexpr size_t WS_OUT = 454 * MiB;
constexpr size_t WS_ACT = 584 * MiB;
constexpr size_t WS_Q = 942 * MiB, WS_K = 1072 * MiB, WS_V = 1105 * MiB;
constexpr size_t WS_U = 942 * MiB;
constexpr size_t WS_XB = 1138 * MiB;
constexpr size_t WS_Y = 584 * MiB;
constexpr size_t WS_PART = 1268 * MiB;
constexpr size_t WS_MODP = 1312 * MiB;
constexpr size_t WS_END = 1320 * MiB;
constexpr int CW_BAR = 4096;

constexpr int LDS_BYTES = 163840;
constexpr int MISC_OFF = 163840 - 256;

template <int CTRL> __device__ __forceinline__ float dppmov(float v) { return __int_as_float(__builtin_amdgcn_update_dpp(0, __float_as_int(v), CTRL, 0xf, 0xf, true)); }
__device__ __forceinline__ float wave_sum(float v) {
    v += dppmov<0xB1>(v);
    v += dppmov<0x4E>(v);
    v += dppmov<0x141>(v);
    v += dppmov<0x140>(v);
    v += __shfl_xor(v, 16);
    v += __shfl_xor(v, 32);
    return v;
}
__device__ __forceinline__ float wave_max(float v) {
#pragma unroll
    for (int o = 1; o < 64; o <<= 1) v = fmaxf(v, __shfl_xor(v, o));
    return v;
}
typedef unsigned tu32x2 __attribute__((ext_vector_type(2)));
typedef float tf32x2 __attribute__((ext_vector_type(2))); typedef __bf16 tbf16x2 __attribute__((ext_vector_type(2)));
__device__ __forceinline__ unsigned cvt2bf(float lo, float hi) { tf32x2 v = {lo, hi}; tbf16x2 b = __builtin_convertvector(v, tbf16x2); return __builtin_bit_cast(unsigned, b); }
__device__ __forceinline__ float bflo(unsigned w) { return __uint_as_float(w << 16); }
__device__ __forceinline__ float bfhi(unsigned w) { return __uint_as_float(w & 0xffff0000u); }

namespace pg8 {
struct EpiPartial {
    static constexpr bool PERM = false, AFTER_DRAIN = false;
    float* P; int ldc; int row_base; size_t slab;
    __device__ __forceinline__ void operator()(const f32x4 (&acc)[2][2][4][2], const Unit& u, int wr, int wc, int fr, int fq) const {
        const int row0 = u.pm * BM - row_base + wr * 64 + fr, col0 = u.pn * BM + wc * 32 + 4 * fq;
        float* base = P + (size_t)u.ks * slab;
#pragma unroll
        for (int ai = 0; ai < 2; ++ai)
#pragma unroll
            for (int m = 0; m < 4; ++m) { float* rowp = base + (size_t)(row0 + ai * HALF + m * 16) * ldc + col0;
#pragma unroll
                for (int bj = 0; bj < 2; ++bj)
#pragma unroll
                    for (int n = 0; n < 2; ++n) *(f32x4*)(rowp + bj * HALF + n * 16) = acc[ai][bj][m][n]; }
    }
};
struct EpiPlain {
    static constexpr bool PERM = true, AFTER_DRAIN = false;
    bf16_t* O; int ldc;
    __device__ __forceinline__ void operator()(const f32x4 (&acc)[2][2][4][2], const Unit& u, int wr, int wc, int fr, int fq) const {
        const int row0 = u.pm * BM + wr * 64 + fr, col0 = u.pn * BM + wc * 32 + 8 * fq;
#pragma unroll
        for (int ai = 0; ai < 2; ++ai)
#pragma unroll
            for (int m = 0; m < 4; ++m) { bf16_t* rowp = O + (size_t)(row0 + ai * HALF + m * 16) * ldc + col0;
#pragma unroll
                for (int bj = 0; bj < 2; ++bj) { const f32x4 v0 = acc[ai][bj][m][0], v1 = acc[ai][bj][m][1];
                    u32x4 w; w.x = cvt_pk_bf16(v0[0], v0[1]); w.y = cvt_pk_bf16(v0[2], v0[3]); w.z = cvt_pk_bf16(v1[0], v1[1]); w.w = cvt_pk_bf16(v1[2], v1[3]);
                    *(u32x4*)(rowp + bj * HALF) = w; } }
    }
};
template <int MODE> struct EpiGated {
    static constexpr bool PERM = true, AFTER_DRAIN = false;
    bf16_t* O; int ldc;
    __device__ __forceinline__ void operator()(const f32x4 (&acc)[2][2][4][2], const Unit& u, int wr, int wc, int fr, int fq) const {
        const int row0 = u.pm * BM + wr * 64 + fr, col0 = u.pn * (BM / 2) + wc * 16 + 4 * (fq & ~1);
#pragma unroll
        for (int ai = 0; ai < 2; ++ai)
#pragma unroll
            for (int mp = 0; mp < 2; ++mp) {
                bf16_t* rowp = O + (size_t)(row0 + ai * HALF + (2 * mp + (fq & 1)) * 16) * ldc + col0;
#pragma unroll
                for (int bj = 0; bj < 2; ++bj) {
                    unsigned pw[2][2];
#pragma unroll
                    for (int mm = 0; mm < 2; ++mm) { const f32x4 v0 = acc[ai][bj][2 * mp + mm][0], v1 = acc[ai][bj][2 * mp + mm][1];
#pragma unroll
                        for (int e2 = 0; e2 < 2; ++e2) { typedef float f2 __attribute__((ext_vector_type(2)));
                            const f2 a = {v0[2 * e2], v0[2 * e2 + 1]}, b = {v1[2 * e2], v1[2 * e2 + 1]};
                            const f2 t = (MODE == 0 ? a : b) * (f2){-1.4426950408889634f, -1.4426950408889634f};
                            const f2 den = (f2){__builtin_amdgcn_exp2f(t[0]), __builtin_amdgcn_exp2f(t[1])} + (f2){1.0f, 1.0f};
                            const f2 rc = {__builtin_amdgcn_rcpf(den[0]), __builtin_amdgcn_rcpf(den[1])};
                            f2 r = a * rc; if (MODE == 0) r = r * b;
                            pw[mm][e2] = cvt_pk_bf16(r[0], r[1]); } }
                    const auto sx = __builtin_amdgcn_permlane16_swap(pw[0][0], pw[1][0], false, false);
                    const auto sy = __builtin_amdgcn_permlane16_swap(pw[0][1], pw[1][1], false, false);
                    u32x4 w; w.x = sx[0]; w.y = sy[0]; w.z = sx[1]; w.w = sy[1];
                    *(u32x4*)(rowp + bj * (HALF / 2)) = w; } }
    }
};
struct EpiQKV {
    static constexpr bool PERM = true, AFTER_DRAIN = false;
    bf16_t* Q; bf16_t* K; bf16_t* V; const float* rope; float qscale;
    __device__ __forceinline__ void operator()(const f32x4 (&acc)[2][2][4][2], const Unit& u, int wr, int wc, int fr, int fq) const {
        const int row0 = u.pm * BM + wr * 64 + fr; const int pn = u.pn;
        if (pn >= 10) {
            const int col0 = (pn - 10) * BM + wc * 32 + 8 * fq;
#pragma unroll
            for (int ai = 0; ai < 2; ++ai)
#pragma unroll
                for (int m = 0; m < 4; ++m) { bf16_t* rowp = V + (size_t)(row0 + ai * HALF + m * 16) * KVD + col0;
#pragma unroll
                    for (int bj = 0; bj < 2; ++bj) { const f32x4 v0 = acc[ai][bj][m][0], v1 = acc[ai][bj][m][1];
                        u32x4 w; w.x = cvt_pk_bf16(v0[0], v0[1]); w.y = cvt_pk_bf16(v0[2], v0[3]); w.z = cvt_pk_bf16(v1[0], v1[1]); w.w = cvt_pk_bf16(v1[2], v1[3]);
                        *(u32x4*)(rowp + bj * HALF) = w; } }
            return;
        }
        const bool isq = pn < 8; const bool lat = u.pm < (MLAT / BM);
        const float sc = isq ? qscale : 1.0f;
        const int tcol = (wc >> 1) * 32 + 16 * (wc & 1) + 4 * fq;
#pragma unroll
        for (int ai = 0; ai < 2; ++ai)
#pragma unroll
            for (int m = 0; m < 4; ++m) {
                const int row = row0 + ai * HALF + m * 16;
                f32x4 t0 = (f32x4){1.f, 0.f, 1.f, 0.f}, t1 = (f32x4){1.f, 0.f, 1.f, 0.f};
                if (lat) { const f32x4* tp = (const f32x4*)(rope + ((size_t)(row & (SEQ - 1)) * 64 + tcol) * 2); t0 = tp[0]; t1 = tp[1]; }
#pragma unroll
                for (int bj = 0; bj < 2; ++bj) { const f32x4 v0 = acc[ai][bj][m][0], v1 = acc[ai][bj][m][1];
                    const float a0 = (v0[0] * t0[0] - v0[1] * t0[1]) * sc, a1 = (v0[1] * t0[0] + v0[0] * t0[1]) * sc;
                    const float a2 = (v0[2] * t0[2] - v0[3] * t0[3]) * sc, a3 = (v0[3] * t0[2] + v0[2] * t0[3]) * sc;
                    const float b0 = (v1[0] * t1[0] - v1[1] * t1[1]) * sc, b1 = (v1[1] * t1[0] + v1[0] * t1[1]) * sc;
                    const float b2 = (v1[2] * t1[2] - v1[3] * t1[3]) * sc, b3 = (v1[3] * t1[2] + v1[2] * t1[3]) * sc;
                    u32x4 w; w.x = cvt_pk_bf16(a0, a1); w.y = cvt_pk_bf16(a2, a3); w.z = cvt_pk_bf16(b0, b1); w.w = cvt_pk_bf16(b2, b3);
                    bf16_t* dst = isq ? Q + (size_t)row * D + (pn * 2 + bj) * 128 + wc * 32 + 8 * fq
                                      : K + (size_t)row * KVD + ((pn - 8) * 2 + bj) * 128 + wc * 32 + 8 * fq;
                    *(u32x4*)dst = w; } }
    }
};
struct EpiUg {
    static constexpr bool PERM = true, AFTER_DRAIN = false;
    bf16_t* Ug;
    __device__ __forceinline__ void operator()(const f32x4 (&acc)[2][2][4][2], const Unit& u, int wr, int wc, int fr, int fq) const {
        const int b = u.pm < (MLAT / BM) ? (u.pm >> 6) : (u.pm - MLAT / BM);
        const int tok0 = u.pm < (MLAT / BM) ? CTXL + (u.pm & 63) * BM : 0;
#pragma unroll
        for (int ai = 0; ai < 2; ++ai)
#pragma unroll
            for (int m = 0; m < 4; ++m) { const int tok = tok0 + ai * HALF + wr * 64 + m * 16 + fr;
#pragma unroll
                for (int bj = 0; bj < 2; ++bj) { const f32x4 v0 = acc[ai][bj][m][0], v1 = acc[ai][bj][m][1];
                    const int g = 16 * u.pn + 8 * bj + 2 * wc + (fq >> 1);
                    u32x4 w; w.x = cvt_pk_bf16(v0[0], v0[1]); w.y = cvt_pk_bf16(v0[2], v0[3]); w.z = cvt_pk_bf16(v1[0], v1[1]); w.w = cvt_pk_bf16(v1[2], v1[3]);
                    *(u32x4*)(Ug + ((size_t)(b * 128 + g) * (CTXL + SEQ) + tok) * 16 + (fq & 1) * 8) = w; } }
    }
};
}

struct Args { const float* in[22]; float* out; unsigned char* ws; int ph_lo, ph_hi; };
struct Ctx {
    LAS unsigned char* lds;
    int tid, lane, wave, G, gw, NGW;
    const float* const* in;
    float* out; unsigned char* ws;
};

__device__ __forceinline__ int map_row(int mode, int n, int N) {
    if (mode == 1) { const int half = N >> 1; const int hi = n >= half ? 1 : 0; const int j = n - hi * half; return ((j >> 2) << 3) + hi * 4 + (j & 3); }
    if (mode == 2) { if (n >= 2560) return n; const int head = n >> 7, d = n & 127, a = d >> 6, dd = d & 63, which = dd >> 5, i = dd & 31; return (head << 7) + (a << 6) + 2 * i + which; }
    return n;
}
__device__ __forceinline__ void transpose_item(const float* W, int K, int N, bf16* WT, int mode, LAS float* scr, int item, int lane) {
    const int nblk = N / 32, kb = item / nblk, nb = item % nblk, k0 = 64 * kb, n0 = 32 * nb;
    float v[32];
#pragma unroll
    for (int i = 0; i < 32; ++i) v[i] = __builtin_nontemporal_load(W + (size_t)(k0 + 2 * i + (lane >> 5)) * N + n0 + (lane & 31));
#pragma unroll
    for (int i = 0; i < 32; ++i) scr[(2 * i + (lane >> 5)) * 33 + (lane & 31)] = v[i];
    LDS_WAIT(); asm volatile("" ::: "memory");
    const int c = lane & 7;
#pragma unroll
    for (int j = 0; j < 4; ++j) { const int n = (lane >> 3) + 8 * j; const LAS float* s = scr + (8 * c) * 33 + n;
        v4u o; o.x = cvt2bf(s[0 * 33], s[1 * 33]); o.y = cvt2bf(s[2 * 33], s[3 * 33]); o.z = cvt2bf(s[4 * 33], s[5 * 33]); o.w = cvt2bf(s[6 * 33], s[7 * 33]);
        *(v4u*)(WT + (size_t)map_row(mode, n0 + n, N) * K + k0 + 8 * c) = o; }
    LDS_WAIT(); asm volatile("" ::: "memory");
}
__device__ __forceinline__ float siluf(float x) { return x / (1.0f + __expf(-x)); }

constexpr int I_WIN = (D / 64) * (2 * FF / 32), I_WOUT = (FF / 64) * (D / 32), I_QKV = (D / 64) * (3072 / 32), I_SQ = (D / 64) * (D / 32), I_GLU = (D / 64) * (4096 / 32);
constexpr int CV_WIN0 = 0, CV_WOUT0 = CV_WIN0 + I_WIN, CV_WQKV = CV_WOUT0 + I_WOUT, CV_WO = CV_WQKV + I_QKV, CV_WIN1 = CV_WO + I_SQ, CV_WOUT1 = CV_WIN1 + I_WIN, CV_WIN2 = CV_WOUT1 + I_WOUT,
              CV_WOUT2 = CV_WIN2 + I_WIN, CV_WSIN = CV_WOUT2 + I_WOUT, CV_WGLU = CV_WSIN + I_SQ, CV_WIN3 = CV_WGLU + I_GLU, CV_WOUT3 = CV_WIN3 + I_WIN, CV_END = CV_WOUT3 + I_WOUT;
static_assert(CV_END == 78848, "item count");
constexpr int CV_S2_B = CV_WOUT0, CV_S2_E = CV_WIN1;
constexpr int CV_S5_B = CV_WIN1, CV_S5_E = CV_WIN1 + 14848;
constexpr int CV_S9_B = CV_S5_E, CV_S9_E = CV_S5_E + 10752;
constexpr int CV_P0B_B = CV_S9_E, CV_P0B_E = CV_WOUT2;
constexpr int CV_S12_B = CV_WOUT2, CV_S12_E = CV_WOUT2 + 10752;
constexpr int CV_S15_B = CV_S12_E, CV_S15_E = CV_S12_E + 14848;
constexpr int CV_P0C_B = CV_S15_E, CV_P0C_E = CV_END;
static_assert(CV_S5_E <= CV_WIN2 && CV_S9_E <= CV_WOUT2 && CV_S9_E >= CV_WIN2 && CV_S12_E <= CV_WIN3 && CV_S12_E >= CV_WGLU && CV_S15_E <= CV_END && CV_S15_E >= CV_WOUT3, "slot map");
__device__ __forceinline__ void convert_items(const Ctx& C, const int begin, const int end, const int rank, const int nranks) {
    LAS float* scr = (LAS float*)(C.lds + C.wave * 16384);
    for (int it = begin + rank * NWAVES + C.wave; it < end; it += nranks * NWAVES) {
        int r = it; const float* W; int K, N, mode; bf16* WT;
        if (r < CV_WOUT0) { W = C.in[7]; K = D; N = 2 * FF; mode = 1; WT = (bf16*)(C.ws + WS_WIN); }
        else if (r < CV_WQKV) { r -= CV_WOUT0; W = C.in[8]; K = FF; N = D; mode = 0; WT = (bf16*)(C.ws + WS_WOUT); }
        else if (r < CV_WO) { r -= CV_WQKV; W = C.in[9]; K = D; N = 3072; mode = 2; WT = (bf16*)(C.ws + WS_WQKV); }
        else if (r < CV_WIN1) { r -= CV_WO; W = C.in[10]; K = D; N = D; mode = 0; WT = (bf16*)(C.ws + WS_WO); }
        else if (r < CV_WOUT1) { r -= CV_WIN1; W = C.in[7] + (size_t)1 * D * 2 * FF; K = D; N = 2 * FF; mode = 1; WT = (bf16*)(C.ws + WS_WIN + 1 * WIN_STRIDE); }
        else if (r < CV_WIN2) { r -= CV_WOUT1; W = C.in[8] + (size_t)1 * FF * D; K = FF; N = D; mode = 0; WT = (bf16*)(C.ws + WS_WOUT + 1 * WOUT_STRIDE); }
        else if (r < CV_WOUT2) { r -= CV_WIN2; W = C.in[7] + (size_t)2 * D * 2 * FF; K = D; N = 2 * FF; mode = 1; WT = (bf16*)(C.ws + WS_WIN + 2 * WIN_STRIDE); }
        else if (r < CV_WSIN) { r -= CV_WOUT2; W = C.in[8] + (size_t)2 * FF * D; K = FF; N = D; mode = 0; WT = (bf16*)(C.ws + WS_WOUT + 2 * WOUT_STRIDE); }
        else if (r < CV_WGLU) { r -= CV_WSIN; W = C.in[12]; K = D; N = D; mode = 0; WT = (bf16*)(C.ws + WS_WSIN); }
        else if (r < CV_WIN3) { r -= CV_WGLU; W = C.in[21]; K = D; N = 4096; mode = 1; WT = (bf16*)(C.ws + WS_WGLU); }
        else if (r < CV_WOUT3) { r -= CV_WIN3; W = C.in[7] + (size_t)3 * D * 2 * FF; K = D; N = 2 * FF; mode = 1; WT = (bf16*)(C.ws + WS_WIN + 3 * WIN_STRIDE); }
        else { r -= CV_WOUT3; W = C.in[8] + (size_t)3 * FF * D; K = FF; N = D; mode = 0; WT = (bf16*)(C.ws + WS_WOUT + 3 * WOUT_STRIDE); }
        transpose_item(W, K, N, WT, mode, scr, r, C.lane);
    }
}
__device__ __forceinline__ void filler_convert(const Ctx& C, const int begin, const int end, const int nrem) {
    const int c = (int)blockIdx.x;
    if (c >= nrem && C.G > nrem) convert_items(C, begin, end, c - nrem, C.G - nrem);
    else if (C.G <= nrem) convert_items(C, begin, end, c, C.G);
}
__device__ __forceinline__ void p0_prologue(const Ctx& C) {
    const int lane = C.lane;
    convert_items(C, CV_WIN0, CV_WOUT0, (int)blockIdx.x, C.G);
    convert_items(C, CV_P0B_B, CV_P0B_E, (int)blockIdx.x, C.G);
    convert_items(C, CV_P0C_B, CV_P0C_E, (int)blockIdx.x, C.G);
    {
        float* modp = (float*)(C.ws + WS_MODP);
        const float* cvec = C.in[1]; const float* cctx = C.in[3]; const float* adaw = C.in[4];
        for (int it = C.gw; it < 2 * 72 * 16; it += C.NGW) {
            const int l = it / 1152, r = it % 1152, jb = r / 16, ks = r % 16, j0 = jb * 256 + lane * 4, k0 = ks * 128;
            const float sa0 = siluf(cvec[k0 + lane]), sb0 = siluf(cvec[k0 + 64 + lane]);
            const float sa1 = siluf(cvec[D + k0 + lane]), sb1 = siluf(cvec[D + k0 + 64 + lane]);
            const float sa2 = siluf(cctx[k0 + lane]), sb2 = siluf(cctx[k0 + 64 + lane]);
            f32x4 a0 = (f32x4){0.f, 0.f, 0.f, 0.f}, a1 = a0, a2 = a0;
            const float* wp = adaw + ((size_t)l * D + k0) * NMOD + j0;
#pragma unroll 16
            for (int kk = 0; kk < 64; ++kk) { const f32x4 w = __builtin_nontemporal_load((const f32x4*)(wp + (size_t)kk * NMOD));
                const float s0 = __shfl(sa0, kk), s1 = __shfl(sa1, kk), s2 = __shfl(sa2, kk);
                a0 += w * s0; a1 += w * s1; a2 += w * s2; }
#pragma unroll 16
            for (int kk = 0; kk < 64; ++kk) { const f32x4 w = __builtin_nontemporal_load((const f32x4*)(wp + (size_t)(64 + kk) * NMOD));
                const float s0 = __shfl(sb0, kk), s1 = __shfl(sb1, kk), s2 = __shfl(sb2, kk);
                a0 += w * s0; a1 += w * s1; a2 += w * s2; }
            float* m0 = modp + ((size_t)(ks * 2 + l) * 3) * NMOD + j0;
            *(f32x4*)m0 = a0; *(f32x4*)(m0 + NMOD) = a1; *(f32x4*)(m0 + 2 * NMOD) = a2;
        }
    }
    {
        float* rope = (float*)(C.ws + WS_ROPE);
        for (int idx = C.gw * 64 + lane; idx < SEQ * 64; idx += C.NGW * 64) {
            const int t = idx >> 6, a = (idx >> 5) & 1, i = idx & 31;
            const float pos = (float)(a ? (t & 63) : (t >> 6));
            const float invf = powf(10000.0f, -(float)(2 * i) / 64.0f);
            const float ang = pos * invf; float sn, cs; sincosf(ang, &sn, &cs);
            *(float2*)(rope + (size_t)idx * 2) = make_float2(cs, sn);
        }
    }
}

__device__ __forceinline__ float mod_value(const float* modp, const float* adab, int l, int v, int j) {
    float acc = adab[l * NMOD + j]; const size_t i = (size_t)(l * 3 + v) * NMOD + j;
#pragma unroll
    for (int ks = 0; ks < 16; ++ks) acc += modp[(size_t)ks * (2 * 3 * NMOD) + i];
    return acc;
}
__device__ __forceinline__ void tv_build(const Ctx& C) {
    float* TV = (float*)(C.ws + WS_XCTX); const float* modp = (const float*)(C.ws + WS_MODP); const float* adab = C.in[5]; const float* ng = C.in[6];
    for (int e = C.gw * 64 + C.lane; e < 7 * 3 * D; e += C.NGW * 64) {
        const int cfg = e / (3 * D), v = (e / D) % 3, col = e % D;
        const bool has_post = cfg != 0, has_pre = cfg != 6;
        const int lpost = cfg <= 3 ? 0 : 1, k3 = cfg == 0 ? 0 : (cfg - 1) % 3;
        const int gpost = 2 * k3 + 1, igate = 3 * k3 + 2; const float wgt = k3 == 1 ? 1.0f : 0.5f;
        const int lpre = cfg <= 2 ? 0 : 1, p3 = cfg % 3;
        const int gpre = 2 * p3, ishift = 3 * p3, iscale = 3 * p3 + 1;
        float A = 0.f, B = 0.f, Cc = 0.f;
        if (has_post) A = wgt * mod_value(modp, adab, lpost, v, igate * D + col) * ng[(lpost * 6 + gpost) * D + col];
        if (has_pre) { B = ng[(lpre * 6 + gpre) * D + col] * (1.0f + mod_value(modp, adab, lpre, v, iscale * D + col)); Cc = mod_value(modp, adab, lpre, v, ishift * D + col); }
        float* t = TV + ((size_t)(cfg * 3 + v) * 3) * D + col;
        t[0] = A; t[D] = B; t[2 * D] = Cc;
    }
}

__device__ __forceinline__ void thin_phase(const Ctx& C, const int cfg, bool has_post, int lpost, int gpost, int igate, float wgt,
                                           bool has_pre, int lpre, int gpre, int ishift, int iscale,
                                           const int srck, const int dstk, int nrows, int npart) {
    LAS float* vec = (LAS float*)C.lds;
    { const f32x4* tv = (const f32x4*)((const float*)(C.ws + WS_XCTX) + (size_t)cfg * 9 * D);
#pragma unroll
      for (int i = 0; i < 9; ++i) ((LAS f32x4*)vec)[C.tid + 512 * i] = tv[C.tid + 512 * i]; }
    __syncthreads();
    const bf16* OUTB = (const bf16*)(C.ws + WS_OUT); bf16* HB = (bf16*)(C.ws + WS_H); bf16* XBB = (bf16*)(C.ws + WS_XB);
    const int lane = C.lane;
    for (int row = C.gw; row < nrows; row += C.NGW) {
        const bool lat = row < MLAT; const int v = lat ? (row >> 14) : 2;

        const LAS f32x4* vA = (const LAS f32x4*)(vec + (v * 3 + 0) * D) + lane;
        const LAS f32x4* vB = (const LAS f32x4*)(vec + (v * 3 + 1) * D) + lane;
        const LAS f32x4* vC = (const LAS f32x4*)(vec + (v * 3 + 2) * D) + lane;
        f32x4 x[8];
        if (srck == 0) { const float* xs = lat ? C.in[0] + (size_t)row * D : C.in[2] + (size_t)(row - MLAT) * D;
#pragma unroll
            for (int j = 0; j < 8; ++j) x[j] = __builtin_nontemporal_load((const f32x4*)xs + lane + 64 * j); }
        else { const uint2* xp = (const uint2*)(XBB + (size_t)row * D) + lane;
#pragma unroll
            for (int j = 0; j < 8; ++j) { const tu32x2 w = __builtin_nontemporal_load((const tu32x2*)xp + 64 * j); x[j] = (f32x4){bflo(w.x), bfhi(w.x), bflo(w.y), bfhi(w.y)}; } }
        if (has_post) {
            f32x4 o[8]; float ss = 0.f;
            if (lat || npart == 0) { const uint2* op = (const uint2*)(OUTB + (size_t)row * D) + lane;
#pragma unroll
                for (int j = 0; j < 8; ++j) { const tu32x2 w = __builtin_nontemporal_load((const tu32x2*)op + 64 * j); o[j] = (f32x4){bflo(w.x), bfhi(w.x), bflo(w.y), bfhi(w.y)}; } }
            else { const f32x4* pp = (const f32x4*)((const float*)(C.ws + WS_PART) + (size_t)(row - MLAT) * D) + lane;
#pragma unroll
                for (int j = 0; j < 8; ++j) o[j] = pp[64 * j];
#pragma unroll 1
                for (int ks = 1; ks < npart; ++ks) { const f32x4* pk = pp + (size_t)ks * MCTX * D / 4;
#pragma unroll
                    for (int j = 0; j < 8; ++j) o[j] += pk[64 * j]; } }
#pragma unroll
            for (int j = 0; j < 8; ++j) ss += (o[j][0] * o[j][0] + o[j][1] * o[j][1]) + (o[j][2] * o[j][2] + o[j][3] * o[j][3]);
            const float rstd = rsqrtf(wave_sum(ss) * (1.0f / D) + EPSN);
#pragma unroll
            for (int j = 0; j < 8; ++j) x[j] += vA[64 * j] * (o[j] * rstd);
        }
        if (dstk == 1) { uint2* xq = (uint2*)(XBB + (size_t)row * D) + lane;
#pragma unroll
            for (int j = 0; j < 8; ++j) { tu32x2 w; w.x = cvt2bf(x[j][0], x[j][1]); w.y = cvt2bf(x[j][2], x[j][3]); __builtin_nontemporal_store(w, (tu32x2*)xq + 64 * j); } }
        if (dstk == 2) { float* xd = C.out + (size_t)row * D;
#pragma unroll
            for (int j = 0; j < 8; ++j) __builtin_nontemporal_store(x[j], (f32x4*)xd + lane + 64 * j); }
        if (has_pre) {
            float ss = 0.f;
#pragma unroll
            for (int j = 0; j < 8; ++j) ss += (x[j][0] * x[j][0] + x[j][1] * x[j][1]) + (x[j][2] * x[j][2] + x[j][3] * x[j][3]);
            const float rstd = rsqrtf(wave_sum(ss) * (1.0f / D) + EPSN);
            uint2* hp = (uint2*)(HB + (size_t)row * D) + lane;
#pragma unroll
            for (int j = 0; j < 8; ++j) { const f32x4 h = (x[j] * rstd) * vB[64 * j] + vC[64 * j]; uint2 w; w.x = cvt2bf(h[0], h[1]); w.y = cvt2bf(h[2], h[3]); hp[64 * j] = w; }
        }
    }
    __syncthreads();
}

typedef float f32x16 __attribute__((ext_vector_type(16)));
typedef unsigned u32x4 __attribute__((ext_vector_type(4)));
typedef short s16x4 __attribute__((ext_vector_type(4)));
typedef short v4i16_t __attribute__((ext_vector_type(4)));
typedef float f32x2_t __attribute__((ext_vector_type(2))); typedef __bf16 bf16x2_t __attribute__((ext_vector_type(2)));
__device__ __forceinline__ unsigned cvtpk_s(float lo, float hi) { f32x2_t v = {lo, hi}; bf16x2_t b = __builtin_convertvector(v, bf16x2_t); return __builtin_bit_cast(unsigned, b); }
__device__ __forceinline__ unsigned off_a(unsigned row, unsigned ch) { return 2048u * (row >> 3) + 512u * (ch >> 2) + 64u * (row & 7) + 16u * ((ch & 3) ^ ((row >> 2) & 3)); }
__device__ __forceinline__ s16x4 vtr(LAS const unsigned char* p) { return __builtin_bit_cast(s16x4, __builtin_amdgcn_ds_read_tr16_b64_v4i16((LAS v4i16_t*)p)); }

template <int OFF> __device__ __forceinline__ void vrd8(unsigned alo, unsigned ahi, s16x4 (&v)[8]) {
    asm volatile("ds_read_b64_tr_b16 %0, %8 offset:%10\n\tds_read_b64_tr_b16 %1, %9 offset:%10\n\t"
                 "ds_read_b64_tr_b16 %2, %8 offset:%11\n\tds_read_b64_tr_b16 %3, %9 offset:%11\n\t"
                 "ds_read_b64_tr_b16 %4, %8 offset:%12\n\tds_read_b64_tr_b16 %5, %9 offset:%12\n\t"
                 "ds_read_b64_tr_b16 %6, %8 offset:%13\n\tds_read_b64_tr_b16 %7, %9 offset:%13"
                 : "=&v"(v[0]), "=&v"(v[1]), "=&v"(v[2]), "=&v"(v[3]), "=&v"(v[4]), "=&v"(v[5]), "=&v"(v[6]), "=&v"(v[7])
                 : "v"(alo), "v"(ahi), "n"(OFF), "n"(OFF + 512), "n"(OFF + 1024), "n"(OFF + 1536) : "memory");
}
template <int N> __device__ __forceinline__ void vwait8(s16x4 (&v)[8]) {
    asm volatile("s_waitcnt lgkmcnt(%8)" : "+v"(v[0]), "+v"(v[1]), "+v"(v[2]), "+v"(v[3]), "+v"(v[4]), "+v"(v[5]), "+v"(v[6]), "+v"(v[7]) : "n"(N) : "memory");
}
template <int OFF> __device__ __forceinline__ void krd4(unsigned ke, unsigned ko, u32x4 (&a)[4]) {
    asm volatile("ds_read_b128 %0, %4 offset:%6\n\tds_read_b128 %1, %4 offset:%7\n\tds_read_b128 %2, %5 offset:%6\n\tds_read_b128 %3, %5 offset:%7"
                 : "=&v"(a[0]), "=&v"(a[1]), "=&v"(a[2]), "=&v"(a[3]) : "v"(ke), "v"(ko), "n"(OFF), "n"(OFF + 8192) : "memory");
}
template <int N> __device__ __forceinline__ void kwait4(u32x4 (&a)[4]) {
    asm volatile("s_waitcnt lgkmcnt(%4)" : "+v"(a[0]), "+v"(a[1]), "+v"(a[2]), "+v"(a[3]) : "n"(N) : "memory");
}

__device__ __forceinline__ void attn_mfma(const Ctx& C, const bf16* Q, const bf16* Kb, const bf16* Vb, const float* sink, bf16* O, bool with_ctx) {
    const int lane = C.lane, w = C.wave, r = lane & 31, h = lane >> 5, tid = C.tid;
    LAS unsigned char* lds = C.lds;
    const int vcu = (C.G % 8 == 0) ? ((int)blockIdx.x % 8) * (C.G / 8) + (int)blockIdx.x / 8 : (int)blockIdx.x;
    const int NU = 2048 + (with_ctx ? 32 : 0);
    const int drow = 8 * w + ((lane >> 2) & 7), dch0 = 4 * (lane >> 5) + ((lane & 3) ^ ((drow >> 2) & 3));
    const unsigned blk = (lane >> 4) & 1, tq = (lane & 15) >> 2, tp = lane & 3;
    const unsigned ke0 = (unsigned)(size_t)lds + 2048u * (r >> 3) + 64u * (r & 7) + 16u * ((unsigned)h ^ ((r >> 2) & 3));
    const unsigned ko0 = (unsigned)(size_t)lds + 2048u * (r >> 3) + 64u * (r & 7) + 16u * ((unsigned)(2 + h) ^ ((r >> 2) & 3));
    const unsigned vlo0 = (unsigned)(size_t)lds + 64u * (4 * h + tq) + 16u * ((2 * blk + (tp >> 1)) ^ (unsigned)h) + 8u * (tp & 1);
    const unsigned vhi0 = (unsigned)(size_t)lds + 2048u + 64u * (4 * h + tq) + 16u * ((2 * blk + (tp >> 1)) ^ (unsigned)(h + 2)) + 8u * (tp & 1);
    const int sinkv = __builtin_bit_cast(int, sink[lane & 15] * 1.4426950408889634f);
    const int qs = (w < 4) ? (w & 3) : 3 - (w & 3);
    const bool late = w >= 4;
    int ksl = 0, vsl = 0;
    for (int u = vcu; u < NU; u += C.G) {
        int b, n, hk, gp; const bool isctx = u >= 2048;
        if (!isctx) { gp = u & 1; hk = (u >> 1) & 3; n = (u >> 3) & 127; b = u >> 10; }
        else { const int v = u - 2048; gp = v & 1; hk = (v >> 1) & 3; n = (v >> 3) & 1; b = v >> 4; }
        const int hd = hk * 4 + gp * 2 + (w >> 2);
        const int qrow0 = isctx ? MLAT + b * CTXL + n * 128 : b * SEQ + n * 128;
        const int qi = 32 * qs + r;
        bf16x8 qf[8];
        f32x16 Oacc[4];
#pragma unroll
        for (int dt = 0; dt < 4; ++dt)
#pragma unroll
            for (int i = 0; i < 16; ++i) Oacc[dt][i] = 0.f;
        float m = __builtin_bit_cast(float, __builtin_amdgcn_readlane(sinkv, __builtin_amdgcn_readfirstlane(hd))), l = h == 0 ? 1.0f : 0.0f;
        int ti = isctx ? 6 : (n == 0 ? 2 : 0);
#define ATT_TILE_ROW(t_) ((t_) < 6 ? (size_t)b * SEQ + (size_t)(n - 1 + ((t_) >> 1)) * 128 + ((t_) & 1) * 64 : (size_t)MLAT + b * CTXL + ((t_) - 6) * 64)
#define ATT_DMA(src_, t_, dstoff_) do { const unsigned char* g_ = (const unsigned char*)((src_) + (ATT_TILE_ROW(t_) + drow) * KVD + hk * 128) + dch0 * 16; \
            __builtin_amdgcn_global_load_lds((const unsigned*)g_, (LAS unsigned*)(lds + (dstoff_) + 2048 * w), 16, 0, 0); \
            __builtin_amdgcn_global_load_lds((const unsigned*)(g_ + 128), (LAS unsigned*)(lds + (dstoff_) + 2048 * w + 1024), 16, 0, 0); } while (0)
#define ATT_DMAKV(t_, ks_, vs_) do { ATT_DMA(Kb, t_, (ks_) * 16384); ATT_DMA(Vb, t_, 49152 + (vs_) * 16384); } while (0)
#define ATT_NEXT(t_) (((t_) + 1 == 4 && !isctx && n == 127) ? 6 : (t_) + 1)
        ATT_DMAKV(ti, ksl, vsl);
        { const u32x4* qp = (const u32x4*)(Q + (size_t)(qrow0 + qi) * D + hd * 128);
#pragma unroll
          for (int s = 0; s < 8; ++s) qf[s] = __builtin_bit_cast(bf16x8, __builtin_nontemporal_load(qp + 2 * s + h)); }
        asm volatile("" : "+v"(qf[0]), "+v"(qf[1]), "+v"(qf[2]), "+v"(qf[3]), "+v"(qf[4]), "+v"(qf[5]), "+v"(qf[6]), "+v"(qf[7]));
        ATT_DMAKV(ATT_NEXT(ti), (ksl == 2 ? 0 : ksl + 1), ((vsl + 1) & 3));
        asm volatile("s_waitcnt vmcnt(4)" ::: "memory");
        asm volatile("s_waitcnt lgkmcnt(0)\n\ts_barrier" ::: "memory");
        bool pend = false; unsigned palo = 0, pahi = 0; u32x4 pw[4];
#define ATT_PVG(g_) do { vwait8<((g_) < 3 ? 8 : 0)>(vv[(g_) & 1]); const bf16x8 pb = __builtin_bit_cast(bf16x8, pw[g_]); \
                    _Pragma("unroll") for (int dt = 0; dt < 4; ++dt) { \
                        const s16x4 lo = vv[(g_) & 1][2 * dt], hi = vv[(g_) & 1][2 * dt + 1]; \
                        const bf16x8 va = (bf16x8){lo[0], lo[1], lo[2], lo[3], hi[0], hi[1], hi[2], hi[3]}; \
                        Oacc[dt] = __builtin_amdgcn_mfma_f32_32x32x16_bf16(va, pb, Oacc[dt], 0, 0, 0); } \
                    if ((g_) < 2) vrd8<49152 + 4096 * ((g_) + 2 < 3 ? (g_) + 2 : 3)>(palo, pahi, vv[(g_) & 1]);        \
                    __builtin_amdgcn_sched_barrier(0); } while (0)
#define ATT_PVALL() do { s16x4 vv[2][8]; vrd8<49152>(palo, pahi, vv[0]); vrd8<49152 + 4096>(palo, pahi, vv[1]); ATT_PVG(0); ATT_PVG(1); ATT_PVG(2); ATT_PVG(3); } while (0)
        for (;;) {
            const int tn = ATT_NEXT(ti); const bool more = tn < 10;
            const int tnn = ATT_NEXT(tn); const bool more2 = more && tnn < 10;
            const int kn = ksl == 2 ? 0 : ksl + 1, kw = kn == 2 ? 0 : kn + 1, vn = (vsl + 1) & 3, vw = (vsl + 2) & 3;
            if (more2) ATT_DMAKV(tnn, kw, vw);
            if (pend) { ATT_PVALL(); pend = false; }
            const int mtp = (ti < 6) ? (ti >> 1) : 1;
            const int kbase = (ti & 1) * 64;
            const bool skip = (mtp == 0 && kbase + 63 < 32 * qs) || (mtp == 2 && kbase > 32 * qs + 31);
            const bool needmask = (mtp == 0 && kbase < 32 * qs + 31) || (mtp == 2 && kbase + 63 > 32 * qs);
            if (!skip) {
                f32x16 S0, S1;
#pragma unroll
                for (int i = 0; i < 16; ++i) { S0[i] = 0.f; S1[i] = 0.f; }
                { u32x4 ka[4][4];
                  const unsigned ke = ke0 + ksl * 16384, ko = ko0 + ksl * 16384;
                  krd4<0>(ke, ko, ka[0]); krd4<512>(ke, ko, ka[1]); krd4<1024>(ke, ko, ka[2]); krd4<1536>(ke, ko, ka[3]);
#define ATT_QK(j_, n_) do { kwait4<n_>(ka[j_]); \
                      S0 = __builtin_amdgcn_mfma_f32_32x32x16_bf16(__builtin_bit_cast(bf16x8, ka[j_][0]), qf[2 * (j_)], S0, 0, 0, 0); \
                      S1 = __builtin_amdgcn_mfma_f32_32x32x16_bf16(__builtin_bit_cast(bf16x8, ka[j_][1]), qf[2 * (j_)], S1, 0, 0, 0); \
                      S0 = __builtin_amdgcn_mfma_f32_32x32x16_bf16(__builtin_bit_cast(bf16x8, ka[j_][2]), qf[2 * (j_) + 1], S0, 0, 0, 0); \
                      S1 = __builtin_amdgcn_mfma_f32_32x32x16_bf16(__builtin_bit_cast(bf16x8, ka[j_][3]), qf[2 * (j_) + 1], S1, 0, 0, 0); \
                      __builtin_amdgcn_sched_barrier(0); } while (0)
                  ATT_QK(0, 12); ATT_QK(1, 8); ATT_QK(2, 4); ATT_QK(3, 0);
#undef ATT_QK
                }
                if (needmask) {
                    const int thr = qi - kbase - 4 * h;
                    if (mtp == 0) {
#pragma unroll
                        for (int i = 0; i < 16; ++i) { const int c = (i & 3) + 8 * (i >> 2); if (c < thr) S0[i] = -__builtin_inff(); if (c + 32 < thr) S1[i] = -__builtin_inff(); }
                    } else {
#pragma unroll
                        for (int i = 0; i < 16; ++i) { const int c = (i & 3) + 8 * (i >> 2); if (c > thr) S0[i] = -__builtin_inff(); if (c + 32 > thr) S1[i] = -__builtin_inff(); }
                    }
                }
                float mx = fmaxf(S0[0], S1[0]);
#pragma unroll
                for (int i = 1; i < 16; ++i) mx = fmaxf(mx, fmaxf(S0[i], S1[i]));
                mx = fmaxf(mx, __shfl_xor(mx, 32));
                if (__any(mx > m + 8.0f)) {
                    const float mn = fmaxf(m, mx), alpha = __builtin_amdgcn_exp2f(m - mn); m = mn; l *= alpha;
#pragma unroll
                    for (int dt = 0; dt < 4; ++dt)
#pragma unroll
                        for (int i = 0; i < 16; ++i) Oacc[dt][i] *= alpha;
                }
                float rs = 0.f;
#pragma unroll
                for (int i = 0; i < 16; ++i) { S0[i] = __builtin_amdgcn_exp2f(S0[i] - m); S1[i] = __builtin_amdgcn_exp2f(S1[i] - m); rs += S0[i] + S1[i]; }
                l += rs;
#pragma unroll
                for (int s2 = 0; s2 < 2; ++s2) {
                    pw[s2].x = cvtpk_s(S0[8 * s2 + 0], S0[8 * s2 + 1]); pw[s2].y = cvtpk_s(S0[8 * s2 + 2], S0[8 * s2 + 3]); pw[s2].z = cvtpk_s(S0[8 * s2 + 4], S0[8 * s2 + 5]); pw[s2].w = cvtpk_s(S0[8 * s2 + 6], S0[8 * s2 + 7]);
                    pw[2 + s2].x = cvtpk_s(S1[8 * s2 + 0], S1[8 * s2 + 1]); pw[2 + s2].y = cvtpk_s(S1[8 * s2 + 2], S1[8 * s2 + 3]); pw[2 + s2].z = cvtpk_s(S1[8 * s2 + 4], S1[8 * s2 + 5]); pw[2 + s2].w = cvtpk_s(S1[8 * s2 + 6], S1[8 * s2 + 7]); }
                palo = vlo0 + vsl * 16384; pahi = vhi0 + vsl * 16384;
                if (late) pend = true; else ATT_PVALL();
            }
            if (more2) { asm volatile("s_waitcnt vmcnt(4)" ::: "memory"); } else { asm volatile("s_waitcnt vmcnt(0)" ::: "memory"); }
            asm volatile("s_waitcnt lgkmcnt(0)\n\ts_barrier" ::: "memory");
            if (!more) { ksl = kn; vsl = vn; break; }
            ti = tn; ksl = kn; vsl = vn;
        }
        if (pend) ATT_PVALL();
#undef ATT_PVG
#undef ATT_PVALL
        const float lt = l + __shfl_xor(l, 32), inv = 1.0f / lt;
        bf16* orow = O + (size_t)(qrow0 + qi) * D + hd * 128 + (h ? 8 : 0);
#pragma unroll
        for (int dt = 0; dt < 4; ++dt)
#pragma unroll
            for (int gp2 = 0; gp2 < 2; ++gp2) {
                unsigned ax = cvtpk_s(Oacc[dt][8 * gp2 + 0] * inv, Oacc[dt][8 * gp2 + 1] * inv), ay = cvtpk_s(Oacc[dt][8 * gp2 + 2] * inv, Oacc[dt][8 * gp2 + 3] * inv);
                unsigned bx = cvtpk_s(Oacc[dt][8 * gp2 + 4] * inv, Oacc[dt][8 * gp2 + 5] * inv), by = cvtpk_s(Oacc[dt][8 * gp2 + 6] * inv, Oacc[dt][8 * gp2 + 7] * inv);
                const auto rx = __builtin_amdgcn_permlane32_swap(ax, bx, false, false); const auto ry = __builtin_amdgcn_permlane32_swap(ay, by, false, false);
                u32x4 wv; wv.x = rx[0]; wv.y = ry[0]; wv.z = rx[1]; wv.w = ry[1];
                *(u32x4*)(orow + 32 * dt + 16 * gp2) = wv; }
#undef ATT_TILE_ROW
#undef ATT_DMA
#undef ATT_DMAKV
#undef ATT_NEXT
    }
}

__device__ __forceinline__ float gelu_tanh(float x) { const float z2 = 1.5957691216057308f * (x + 0.044715f * x * x * x); return x * __builtin_amdgcn_rcpf(1.0f + __expf(-z2)); }

constexpr int TOKS = CTXL + SEQ;
constexpr int NCHK = 130;
constexpr int SS_KT = 131072, SS_KTD = 4608, SS_ST = SS_KT + 2 * SS_KTD;
constexpr int ST_F = 1152, ST_A16 = 1280, ST_A32 = 1408, ST_A64 = 1536, ST_A128 = 1664;
__device__ __forceinline__ unsigned swzb(unsigned row, unsigned chunk) { return row * 256u + ((chunk ^ (row & 15u)) << 4); }
template <int CTRL> __device__ __forceinline__ float dppf(float v) { return __int_as_float(__builtin_amdgcn_update_dpp(0, __float_as_int(v), CTRL, 0xf, 0xf, true)); }
template <int CTRL> __device__ __forceinline__ float dppfo(float o, float v) { return __int_as_float(__builtin_amdgcn_update_dpp(__float_as_int(o), __float_as_int(v), CTRL, 0xf, 0xf, false)); }
template <int CTRL> __device__ __forceinline__ f32x4 dpp4o(const f32x4 o, const f32x4 v) { return (f32x4){dppfo<CTRL>(o[0], v[0]), dppfo<CTRL>(o[1], v[1]), dppfo<CTRL>(o[2], v[2]), dppfo<CTRL>(o[3], v[3])}; }
template <int CTRL> __device__ __forceinline__ f32x4 dpp4(const f32x4 v) { return (f32x4){dppf<CTRL>(v[0]), dppf<CTRL>(v[1]), dppf<CTRL>(v[2]), dppf<CTRL>(v[3])}; }
__device__ __forceinline__ f32x4 cmul2(const f32x4 m, const f32x4 x) { return (f32x4){m[0] * x[0] - m[1] * x[1], m[0] * x[1] + m[1] * x[0], m[2] * x[2] - m[3] * x[3], m[2] * x[3] + m[3] * x[2]}; }
__device__ __forceinline__ f32x4 cfma2(const f32x4 m, const f32x4 x, const f32x4 s) {
    f32x2_t s0 = {s[0], s[1]}, s1 = {s[2], s[3]};
    const f32x2_t m0 = {m[0], m[1]}, m1 = {m[2], m[3]}, x0 = {x[0], x[1]}, x1 = {x[2], x[3]};
    asm("v_pk_fma_f32 %0, %1, %2, %0 op_sel_hi:[0,1,1]\n\tv_pk_fma_f32 %0, %1, %2, %0 op_sel:[1,1,0] op_sel_hi:[1,0,1] neg_lo:[1,0,0]" : "+v"(s0) : "v"(m0), "v"(x0));
    asm("v_pk_fma_f32 %0, %1, %2, %0 op_sel_hi:[0,1,1]\n\tv_pk_fma_f32 %0, %1, %2, %0 op_sel:[1,1,0] op_sel_hi:[1,0,1] neg_lo:[1,0,0]" : "+v"(s1) : "v"(m1), "v"(x1));
    return (f32x4){s0[0], s0[1], s1[0], s1[1]};
}
#define MFMA16(a, b, c) __builtin_amdgcn_mfma_f32_16x16x32_bf16((a), (b), (c), 0, 0, 0)

__device__ __forceinline__ void ssm_load_u(const int d, const int k, const bf16* Ugbg, const int lane_in, bf16x8 (&uf)[4]) {
    int lane = lane_in; asm volatile("" : "+v"(lane));
    const int n = lane & 15, q = lane >> 4;
    const int pb = k < 2 ? 0 : CTXL, pl = k < 2 ? CTXL : SEQ, kk = k < 2 ? k : k - 2;
#pragma unroll
    for (int ks = 0; ks < 4; ++ks) { const int idx = kk * 128 + n * 8 + 2 * ks + (q >> 1); const int tok = pb + (d ? pl - 1 - idx : idx);
        uf[ks] = *(const bf16x8*)(Ugbg + (size_t)tok * 16 + 8 * (q & 1)); }
}
template <int MODE> __device__ __forceinline__ void ssm_chunk(LAS const unsigned char* lds, const int d, const bf16x8 (&uf)[4], f32x4 (&hc)[8], const float* Hnext, float* Ek, f32x4 (&acc)[8], const int lane_in) {
    int lane = lane_in; asm volatile("" : "+v"(lane));
    const int n = lane & 15, q = lane >> 4;
    LAS const unsigned char* Pt = lds + d * 65536; LAS const unsigned char* Rt = Pt + 32768;
    LAS const unsigned char* Kt = lds + SS_KT + d * SS_KTD; LAS const float* ST = (LAS const float*)(lds + SS_ST + d * 7168);
    f32x4 S[8];
    { bf16x8 pa[2][8];
#pragma unroll
      for (int j = 0; j < 8; ++j) pa[0][j] = *(LAS const bf16x8*)(Pt + swzb(16 * (j >> 2) + n, 4 * (j & 3) + q));
#pragma unroll
      for (int mb = 0; mb < 4; ++mb) {
          if (mb < 3) {
#pragma unroll
              for (int j = 0; j < 8; ++j) pa[(mb + 1) & 1][j] = *(LAS const bf16x8*)(Pt + swzb(16 * (2 * mb + 2 + (j >> 2)) + n, 4 * (j & 3) + q)); }
#pragma unroll
          for (int j = 0; j < 8; ++j) { const int m = 2 * mb + (j >> 2); if ((j & 3) == 0) S[m] = (f32x4){0.f, 0.f, 0.f, 0.f}; S[m] = MFMA16(pa[mb & 1][j], uf[j & 3], S[m]); }
          __builtin_amdgcn_sched_barrier(0); } }
    f32x4 mmv[8];
#pragma unroll
    for (int m = 0; m < 8; ++m) mmv[m] = *(LAS const f32x4*)(ST + 8 * 128 + (8 * m + 2 * q) * 2);
    if (MODE == 1) {
        { const float z = n == 0 ? 1.0f : 0.0f;
#pragma unroll
          for (int m = 0; m < 8; ++m) S[m] = cfma2(mmv[m], hc[m] * z, S[m]); }
        __builtin_amdgcn_sched_barrier(0);
    }
#pragma unroll
    for (int m = 0; m < 8; ++m) S[m] = cfma2(mmv[m], dpp4<0x111>(S[m]), S[m]);
    __builtin_amdgcn_sched_barrier(0);
#pragma unroll
    for (int m = 0; m < 8; ++m) mmv[m] = *(LAS const f32x4*)(ST + ST_A16 + (8 * m + 2 * q) * 2);
#pragma unroll
    for (int m = 0; m < 8; ++m) S[m] = cfma2(mmv[m], dpp4<0x112>(S[m]), S[m]);
    __builtin_amdgcn_sched_barrier(0);
#pragma unroll
    for (int m = 0; m < 8; ++m) mmv[m] = *(LAS const f32x4*)(ST + ST_A32 + (8 * m + 2 * q) * 2);
#pragma unroll
    for (int m = 0; m < 8; ++m) S[m] = cfma2(mmv[m], dpp4<0x114>(S[m]), S[m]);
    __builtin_amdgcn_sched_barrier(0);
#pragma unroll
    for (int m = 0; m < 8; ++m) mmv[m] = *(LAS const f32x4*)(ST + ST_A64 + (8 * m + 2 * q) * 2);
#pragma unroll
    for (int m = 0; m < 8; ++m) S[m] = cfma2(mmv[m], dpp4<0x118>(S[m]), S[m]);
    __builtin_amdgcn_sched_barrier(0);
    if (MODE == 0) {
        if (n == 15) {
#pragma unroll
            for (int m = 0; m < 8; ++m) *(f32x4*)(Ek + (8 * m + 2 * q) * 2) = S[m]; }
        return;
    }
    bf16x8 hb[4];
#pragma unroll
    for (int ks2 = 0; ks2 < 4; ++ks2) {
        const f32x4 h0 = dpp4o<0x111>(hc[2 * ks2], S[2 * ks2]), h1 = dpp4o<0x111>(hc[2 * ks2 + 1], S[2 * ks2 + 1]);
        u32x4 w; w.x = cvtpk_s(h0[0], h0[1]); w.y = cvtpk_s(h0[2], h0[3]); w.z = cvtpk_s(h1[0], h1[1]); w.w = cvtpk_s(h1[2], h1[3]);
        hb[ks2] = __builtin_bit_cast(bf16x8, w);
    }
    __builtin_amdgcn_sched_barrier(0);
#pragma unroll
    for (int m = 0; m < 8; ++m) hc[m] = *(const f32x4*)(Hnext + (8 * m + 2 * q) * 2);
    __builtin_amdgcn_sched_barrier(0);
    u32x4 ra[2][4], kq[2][4];
#define SSM_LOADT(t_, b_) do { _Pragma("unroll") for (int ks2 = 0; ks2 < 4; ++ks2) ra[b_][ks2] = *(LAS const u32x4*)(Rt + swzb(16 * (t_) + n, 4 * ks2 + q)); \
        _Pragma("unroll") for (int ks = 0; ks <= (t_) / 2; ++ks) kq[b_][ks] = *(LAS const u32x4*)(Kt + ((t_) - 2 * ks - (q >> 1) + 1) * 512 + n * 32 + (q & 1) * 16); } while (0)
    SSM_LOADT(0, 0);
#pragma unroll
    for (int t = 0; t < 8; ++t) {
        if (t < 7) SSM_LOADT(t + 1, (t + 1) & 1);
#pragma unroll
        for (int ks2 = 0; ks2 < 4; ++ks2) acc[t] = MFMA16(__builtin_bit_cast(bf16x8, ra[t & 1][ks2]), hb[ks2], acc[t]);
#pragma unroll
        for (int ks = 0; ks <= t / 2; ++ks) acc[t] = MFMA16(__builtin_bit_cast(bf16x8, kq[t & 1][ks]), uf[ks], acc[t]);
        __builtin_amdgcn_sched_barrier(0);
    }
#undef SSM_LOADT
}

__device__ __forceinline__ void ssm_phase(const Ctx& C, const bf16* Ug, float* EH, bf16* Gout) {
    const int tid_in = C.tid, tid = C.tid, lane = C.lane, w = C.wave;
    LAS unsigned char* lds = C.lds;
    const float* a_re = C.in[13]; const float* a_im = C.in[14]; const float* log_dt = C.in[15];
    const float* b_re = C.in[16]; const float* b_im = C.in[17]; const float* c_re = C.in[18]; const float* c_im = C.in[19]; const float* dskip = C.in[20];
    for (int unit = (int)blockIdx.x; unit < 256; unit += C.G) {
        const int xx = unit & 7, yy = unit >> 3, zz = xx * 8 + (yy >> 2), b = zz >> 5, g = (zz & 31) * 4 + (yy & 3);
        LAS unsigned char* stg = lds + 65536 + 32768;
        { f32x4 tmp[4]; int tid = tid_in; asm volatile("" : "+v"(tid));
#pragma unroll
          for (int i = 0; i < 4; ++i) { const int idx = tid + 512 * i, a_ = idx >> 8, off = idx & 255, dg_ = (a_ >> 2) * 128 + g, k_ = a_ & 3;
              const float* src = (k_ == 0 ? b_re : k_ == 1 ? b_im : k_ == 2 ? c_re : c_im) + (size_t)dg_ * 1024;
              tmp[i] = *(const f32x4*)(src + off * 4); }
#pragma unroll
          for (int i = 0; i < 4; ++i) { const int idx = tid + 512 * i; *(LAS f32x4*)(stg + (idx >> 8) * 4096 + (idx & 255) * 16) = tmp[i]; } }
        if (tid < 128) { const int d = tid >> 6, p = tid & 63, dg = d * 128 + g;
            LAS float* ST = (LAS float*)(lds + SS_ST + d * 7168);
            const double are = (double)a_re[dg * 64 + p], aim = (double)a_im[dg * 64 + p], dt = (double)expf(log_dt[dg]);
            const double mg = exp(are * dt); double sn, cs; sincos(aim * dt, &sn, &cs); const double ar1 = mg * cs, ai1 = mg * sn;
            { const double xr = ar1 - 1.0, xi = ai1, den = are * are + aim * aim;
              ST[ST_F + p * 2] = (float)((xr * are + xi * aim) / den); ST[ST_F + p * 2 + 1] = (float)((xi * are - xr * aim) / den); }
            double pr = 1.0, pi = 0.0;
#pragma unroll 1
            for (int j = 0; j <= 8; ++j) { ST[(j * 64 + p) * 2] = (float)pr; ST[(j * 64 + p) * 2 + 1] = (float)pi; const double nr = pr * ar1 - pi * ai1, ni = pr * ai1 + pi * ar1; pr = nr; pi = ni; }
            double qr = ar1, qi = ai1;
#pragma unroll 1
            for (int sq = 0; sq < 3; ++sq) { const double nr = qr * qr - qi * qi, ni = 2.0 * qr * qi; qr = nr; qi = ni; }
#pragma unroll 1
            for (int jj = 0; jj < 4; ++jj) { const double nr = qr * qr - qi * qi, ni = 2.0 * qr * qi; qr = nr; qi = ni;
                ST[ST_A16 + jj * 128 + p * 2] = (float)qr; ST[ST_A16 + jj * 128 + p * 2 + 1] = (float)qi; }
        }
        __syncthreads();
#pragma unroll 1
        for (int d = 0; d < 2; ++d) {
            int tid = tid_in; asm volatile("" : "+v"(tid));
            LAS const float* ST = (LAS const float*)(lds + SS_ST + d * 7168);
            LAS const float* Sbr = (LAS const float*)(stg + d * 16384); LAS const float* Sbi = Sbr + 1024; LAS const float* Scr = Sbr + 2048; LAS const float* Sci = Sbr + 3072;
            LAS unsigned char* Pt = lds + d * 65536; LAS unsigned char* Kt = lds + SS_KT + d * SS_KTD;
            {
              const int col = tid & 127, row0 = tid >> 7, s_ = col >> 4, cp = col & 15, comp = row0 & 1;
#pragma unroll 8
              for (int i = 0; i < 32; ++i) { const int row = row0 + 4 * i, p = row >> 1;
                  const float br = Sbr[p * 16 + cp], bi = Sbi[p * 16 + cp];
                  const float fr = ST[ST_F + p * 2], fi = ST[ST_F + p * 2 + 1], bbr = fr * br - fi * bi, bbi = fr * bi + fi * br;
                  const float ar = ST[((7 - s_) * 64 + p) * 2], ai = ST[((7 - s_) * 64 + p) * 2 + 1];
                  const float v = comp ? ar * bbi + ai * bbr : ar * bbr - ai * bbi;
                  *(LAS bf16*)(Pt + swzb(row, col >> 3) + (col & 7) * 2) = (bf16)f2bf(v); } }
            {
              const int c = (tid >> 4) & 15, cp = tid & 15, lag0 = tid >> 8; float sum[4] = {0.f, 0.f, 0.f, 0.f};
#pragma unroll 8
              for (int p = 0; p < 64; ++p) {
                  const float br = Sbr[p * 16 + cp], bi = Sbi[p * 16 + cp];
                  const float cr = Scr[c * 64 + p], ci = Sci[c * 64 + p];
                  const float fr = ST[ST_F + p * 2], fi = ST[ST_F + p * 2 + 1], bbr = fr * br - fi * bi, bbi = fr * bi + fi * br;
                  const float wr = cr * bbr - ci * bbi, wi = cr * bbi + ci * bbr;
#pragma unroll
                  for (int i = 0; i < 4; ++i) { const int lag = lag0 + 2 * i; const float ar = ST[(lag * 64 + p) * 2], ai = ST[(lag * 64 + p) * 2 + 1]; sum[i] += wr * ar - wi * ai; } }
#pragma unroll
              for (int i = 0; i < 4; ++i) *(LAS bf16*)(Kt + (1 + lag0 + 2 * i) * 512 + c * 32 + cp * 2) = (bf16)f2bf(sum[i]);
              if (tid < 128) ((LAS unsigned*)Kt)[tid] = 0u; }
        }
#pragma unroll 1
        for (int d = 0; d < 2; ++d) {
            int tid = tid_in; asm volatile("" : "+v"(tid));
            LAS const float* ST = (LAS const float*)(lds + SS_ST + d * 7168);
            LAS const float* Scr = (LAS const float*)(stg + d * 16384) + 2048; LAS const float* Sci = Scr + 1024;
            LAS unsigned char* Rt = lds + d * 65536 + 32768;
            {
              const int col = tid & 127, ks2 = col >> 5, kpos = col & 31;
              const int pp = 32 * ks2 + 16 * ((kpos >> 2) & 1) + 4 * (kpos >> 3) + (kpos & 3), p = pp >> 1, comp = pp & 1;
              float cr[4], ci[4];
#pragma unroll
              for (int j = 0; j < 4; ++j) { const int c = (tid >> 7) + 4 * j; cr[j] = Scr[c * 64 + p]; ci[j] = Sci[c * 64 + p]; }
              asm volatile("" : "+v"(cr[0]), "+v"(cr[1]), "+v"(cr[2]), "+v"(cr[3]), "+v"(ci[0]), "+v"(ci[1]), "+v"(ci[2]), "+v"(ci[3]));
              __syncthreads();
#pragma unroll
              for (int t = 0; t < 8; ++t) { const float ar = ST[((t + 1) * 64 + p) * 2], ai = ST[((t + 1) * 64 + p) * 2 + 1];
#pragma unroll
                  for (int j = 0; j < 4; ++j) { const int row = t * 16 + (tid >> 7) + 4 * j;
                      const float v = comp ? -(cr[j] * ai + ci[j] * ar) : cr[j] * ar - ci[j] * ai;
                      *(LAS bf16*)(Rt + swzb(row, col >> 3) + (col & 7) * 2) = (bf16)f2bf(v); } } }
        }
        __syncthreads();
        const bf16* Ugbg = Ug + (size_t)(b * 128 + g) * TOKS * 16;
        float* Eb = EH + (size_t)unit * (4 * NCHK * 128); float* Hb = Eb + 2 * NCHK * 128;
        { f32x4 dummy[8]; bf16x8 ufa[4], ufb[4];
          ssm_load_u(w >= NCHK ? 1 : 0, w >= NCHK ? w - NCHK : w, Ugbg, lane, ufa);
#pragma unroll 1
          for (int cd = w; cd < 2 * NCHK; cd += 2 * NWAVES) {
              const int cd1 = cd + NWAVES, cd2 = cd + 2 * NWAVES;
              { const int c1 = cd1 < 2 * NCHK ? cd1 : cd; const int d1 = c1 >= NCHK ? 1 : 0; ssm_load_u(d1, c1 - d1 * NCHK, Ugbg, lane, ufb); }
              { const int d = cd >= NCHK ? 1 : 0, k = cd - d * NCHK; ssm_chunk<0>(lds, d, ufa, dummy, nullptr, Eb + (size_t)(d * NCHK + k) * 128, dummy, lane); }
              { const int c2 = cd2 < 2 * NCHK ? cd2 : cd; const int d2 = c2 >= NCHK ? 1 : 0; ssm_load_u(d2, c2 - d2 * NCHK, Ugbg, lane, ufa); }
              if (cd1 < 2 * NCHK) { const int d = cd1 >= NCHK ? 1 : 0, k = cd1 - d * NCHK; ssm_chunk<0>(lds, d, ufb, dummy, nullptr, Eb + (size_t)(d * NCHK + k) * 128, dummy, lane); }
          } }
        __syncthreads();
        if (tid < 128) { const int d = tid >> 6, p = tid & 63; LAS const float* ST = (LAS const float*)(lds + SS_ST + d * 7168);
            const float ar = ST[ST_A128 + p * 2], ai = ST[ST_A128 + p * 2 + 1]; float hr = 0.f, hi = 0.f;
            const float2* Ep = (const float2*)(Eb + (size_t)d * NCHK * 128) + p; float2* Hp = (float2*)(Hb + (size_t)d * NCHK * 128) + p;
            float2 e[2][26];
#pragma unroll
            for (int j = 0; j < 26; ++j) e[0][j] = Ep[(size_t)j * 64];
#pragma unroll
            for (int kb = 0; kb < NCHK / 26; ++kb) { const int k0 = 26 * kb;
                if (kb + 1 < NCHK / 26) {
#pragma unroll
                    for (int j = 0; j < 26; ++j) e[(kb + 1) & 1][j] = Ep[(size_t)(k0 + 26 + j) * 64]; }
#pragma unroll
                for (int j = 0; j < 26; ++j) { Hp[(size_t)(k0 + j) * 64] = make_float2(hr, hi); const float nr = ar * hr - ai * hi + e[kb & 1][j].x, ni = ar * hi + ai * hr + e[kb & 1][j].y; hr = nr; hi = ni; } }
        }
        __syncthreads();
        { bf16x8 ufa[4], ufb[4]; f32x4 hcs[8];
          ssm_load_u(0, 2 + w, Ugbg, lane, ufa);
          { int l0 = lane; asm volatile("" : "+v"(l0)); const int q0 = l0 >> 4;
#pragma unroll
            for (int m = 0; m < 8; ++m) hcs[m] = *(const f32x4*)(Hb + (size_t)(2 + w) * 128 + (8 * m + 2 * q0) * 2); }
#pragma unroll 1
          for (int kk = w; kk < 128; kk += NWAVES) {
              int ln = lane; asm volatile("" : "+v"(ln));
              const int n = ln & 15, q = ln >> 4;
              const f32x4 dsk = *(const f32x4*)(dskip + g * 16 + 4 * q);
              f32x4 accf[8], accb[8];
#pragma unroll
              for (int t = 0; t < 8; ++t) { accf[t] = (f32x4){0.f, 0.f, 0.f, 0.f}; accb[t] = (f32x4){0.f, 0.f, 0.f, 0.f}; }
              ssm_load_u(1, 2 + 127 - kk, Ugbg, lane, ufb);
              ssm_chunk<1>(lds, 0, ufa, hcs, Hb + (size_t)(NCHK + 2 + 127 - kk) * 128, nullptr, accf, lane);
              { const int kn = kk + NWAVES < 128 ? kk + NWAVES : kk; ssm_load_u(0, 2 + kn, Ugbg, lane, ufa); }
              uint2 uwv[8];
#pragma unroll
              for (int t = 0; t < 8; ++t) uwv[t] = *(const uint2*)(Ugbg + (size_t)(CTXL + kk * 128 + n * 8 + t) * 16 + 4 * q);
              ssm_chunk<1>(lds, 1, ufb, hcs, Hb + (size_t)(2 + (kk + NWAVES < 128 ? kk + NWAVES : kk)) * 128, nullptr, accb, lane);
#pragma unroll
              for (int tp2 = 0; tp2 < 4; ++tp2) {
                  unsigned gx[2], gy[2];
#pragma unroll
                  for (int tt = 0; tt < 2; ++tt) { const int t = 2 * tp2 + tt;
                      const f32x4 yb = dpp4<0x140>(accb[7 - t]);
                      const uint2 uw = uwv[t];
                      const f32x4 u = (f32x4){bflo(uw.x), bfhi(uw.x), bflo(uw.y), bfhi(uw.y)};
                      const f32x4 y = accf[t] + yb + dsk * u;
                      gx[tt] = cvtpk_s(gelu_tanh(y[0]), gelu_tanh(y[1])); gy[tt] = cvtpk_s(gelu_tanh(y[2]), gelu_tanh(y[3])); }
                  const auto sx = __builtin_amdgcn_permlane16_swap(gx[0], gx[1], false, false); const auto sy = __builtin_amdgcn_permlane16_swap(gy[0], gy[1], false, false);
                  u32x4 gw; gw.x = sx[0]; gw.y = sy[0]; gw.z = sx[1]; gw.w = sy[1];
                  const int tls = kk * 128 + n * 8 + 2 * tp2 + (q & 1);
                  *(u32x4*)(Gout + ((size_t)b * SEQ + tls) * D + g * 16 + 4 * (q & ~1)) = gw; }
          } }
        __syncthreads();
    }
}

constexpr int NPHASE = 22;
#ifndef MK_ONE_LAUNCH
#define MK_ONE_LAUNCH 1
#endif
__global__ void __launch_bounds__(NWAVES * 64, 2) fwd_kernel(Args args) {
    extern __shared__ __attribute__((aligned(16))) unsigned char lds_raw[];
    Ctx C;
    C.lds = (LAS unsigned char*)lds_raw;
    C.tid = threadIdx.x; C.lane = C.tid & 63; C.wave = __builtin_amdgcn_readfirstlane(C.tid >> 6);
    C.G = gridDim.x; C.gw = (int)blockIdx.x * NWAVES + C.wave; C.NGW = C.G * NWAVES;
    C.in = args.in; C.out = args.out; C.ws = args.ws;
    volatile LAS unsigned* MISC = (volatile LAS unsigned*)(C.lds + MISC_OFF);
    if (C.tid < 64) ((LAS unsigned*)(C.lds + MISC_OFF))[C.tid] = 0u;
    __syncthreads();
    XcdBarrier bar; bar.bar = (unsigned*)(C.ws + WS_CTL) + CW_BAR; bar.x = 0; bar.st = nullptr;
    if (MK_ONE_LAUNCH) bar = xcd_barrier_post((unsigned*)(C.ws + WS_CTL) + CW_BAR, MISC + 8);
    const int lo = args.ph_lo, hi = args.ph_hi;
#define IN(k) (lo <= (k) && (k) < hi)
#define SEAM(k) do { if (IN(k) && IN((k) + 1)) xcd_barrier(bar); } while (0)
    unsigned char* ws = C.ws;
    bf16* HB = (bf16*)(ws + WS_H); bf16* OUTB = (bf16*)(ws + WS_OUT); bf16* ACTB = (bf16*)(ws + WS_ACT);
    bf16* QB = (bf16*)(ws + WS_Q); bf16* KB = (bf16*)(ws + WS_K); bf16* VB = (bf16*)(ws + WS_V); bf16* UB = (bf16*)(ws + WS_U);
    float* YB = (float*)(ws + WS_Y); float* XCTX = (float*)(ws + WS_XCTX); float* PARTB = (float*)(ws + WS_PART);
    const float* x_in = C.in[0]; const float* ctx_in = C.in[2];
#define WIN(i) ((const bf16*)(ws + WS_WIN + (size_t)(i) * WIN_STRIDE))
#define WOUT(i) ((const bf16*)(ws + WS_WOUT + (size_t)(i) * WOUT_STRIDE))
#define GEMM_PHASE(EPI_T, EPI, Aptr, Btptr, M_, N_, K_) GEMM_PHASE_W(EPI_T, EPI, Aptr, Btptr, M_, N_, K_, 8)
#define GEMM_PHASE_W(EPI_T, EPI, Aptr, Btptr, M_, N_, K_, WGM_) do { pg8::Gemm g_{(Aptr), (Btptr), (M_), (N_), (K_), (K_), 0}; pg8::StaticOrder S_; S_.init((M_), (N_), C.G, (int)blockIdx.x, (WGM_) & 15, (WGM_) >> 4); \
        pg8::gemm_phase<EPI_T, pg8::StaticOrder, true, true>(C.lds, g_, S_, (EPI)); } while (0)

#define GEMM_CTX_SPLITK(Aptr, Btptr, N_, K_, NKS_) do { pg8::Gemm g_{(Aptr), (Btptr), MALL, (N_), (K_) / (NKS_), (K_), (K_) / (NKS_)}; pg8::SplitKOrder S_; S_.init(MLAT / 256, MCTX / 256, (N_), (NKS_), C.G, (int)blockIdx.x); \
        pg8::EpiPartial E_{PARTB, (N_), MLAT, (size_t)MCTX * (N_)}; pg8::gemm_phase<pg8::EpiPartial, pg8::SplitKOrder, true, true>(C.lds, g_, S_, E_); } while (0)
    if (IN(0)) { p0_prologue(C); } SEAM(0);
    if (IN(1)) { tv_build(C); xcd_barrier(bar); thin_phase(C, 0, false, 0, 0, 0, 0.f, true, 0, 0, 0, 1, 0, 0, MALL, 0); } SEAM(1);
    if (IN(2)) { pg8::EpiGated<0> E{ACTB, FF}; GEMM_PHASE(pg8::EpiGated<0>, E, HB, WIN(0), MALL, 2 * FF, D); filler_convert(C, CV_S2_B, CV_S2_E, (MALL / 256) * (2 * FF / 256) % 256); } SEAM(2);
    if (IN(3)) { pg8::EpiPlain E{OUTB, D}; GEMM_PHASE_W(pg8::EpiPlain, E, ACTB, WOUT(0), MLAT, D, FF, 4 + 16); GEMM_CTX_SPLITK(ACTB, WOUT(0), D, FF, 11); } SEAM(3);
    if (IN(4)) { thin_phase(C, 1, true, 0, 1, 2, 0.5f, true, 0, 2, 3, 4, 0, 1, MALL, 11); } SEAM(4);
    if (IN(5)) { pg8::EpiQKV E{QB, KB, VB, (const float*)(ws + WS_ROPE), 0.08838834764831845f * 1.4426950408889634f}; GEMM_PHASE(pg8::EpiQKV, E, HB, (const bf16*)(ws + WS_WQKV), MALL, 3072, D); filler_convert(C, CV_S5_B, CV_S5_E, (MALL / 256) * (3072 / 256) % 256); } SEAM(5);
    if (IN(6)) { attn_mfma(C, QB, KB, VB, C.in[11], HB, true); } SEAM(6);
    if (IN(7)) { pg8::EpiPlain E{OUTB, D}; GEMM_PHASE(pg8::EpiPlain, E, HB, (const bf16*)(ws + WS_WO), MLAT, D, D); GEMM_CTX_SPLITK(HB, (const bf16*)(ws + WS_WO), D, D, 4); } SEAM(7);
    if (IN(8)) { thin_phase(C, 2, true, 0, 3, 5, 1.0f, true, 0, 4, 6, 7, 1, 1, MALL, 4); } SEAM(8);
    if (IN(9)) { pg8::EpiGated<0> E{ACTB, FF}; GEMM_PHASE(pg8::EpiGated<0>, E, HB, WIN(1), MALL, 2 * FF, D); filler_convert(C, CV_S9_B, CV_S9_E, (MALL / 256) * (2 * FF / 256) % 256); } SEAM(9);
    if (IN(10)) { pg8::EpiPlain E{OUTB, D}; GEMM_PHASE_W(pg8::EpiPlain, E, ACTB, WOUT(1), MLAT, D, FF, 4 + 16); GEMM_CTX_SPLITK(ACTB, WOUT(1), D, FF, 11); } SEAM(10);
    if (IN(11)) { thin_phase(C, 3, true, 0, 5, 8, 0.5f, true, 1, 0, 0, 1, 1, 1, MALL, 11); } SEAM(11);
    if (IN(12)) { pg8::EpiGated<0> E{ACTB, FF}; GEMM_PHASE(pg8::EpiGated<0>, E, HB, WIN(2), MALL, 2 * FF, D); filler_convert(C, CV_S12_B, CV_S12_E, (MALL / 256) * (2 * FF / 256) % 256); } SEAM(12);
    if (IN(13)) { pg8::EpiPlain E{OUTB, D}; GEMM_PHASE_W(pg8::EpiPlain, E, ACTB, WOUT(2), MLAT, D, FF, 4 + 16); GEMM_CTX_SPLITK(ACTB, WOUT(2), D, FF, 11); } SEAM(13);
    if (IN(14)) { thin_phase(C, 4, true, 1, 1, 2, 0.5f, true, 1, 2, 3, 4, 1, 1, MALL, 11); } SEAM(14);
    if (IN(15)) { pg8::EpiUg E{UB}; GEMM_PHASE(pg8::EpiUg, E, HB, (const bf16*)(ws + WS_WSIN), MALL, D, D); filler_convert(C, CV_S15_B, CV_S15_E, (MALL / 256) * (D / 256) % 256); } SEAM(15);
    if (IN(16)) { ssm_phase(C, UB, YB, HB); } SEAM(16);
    if (IN(17)) { pg8::EpiGated<1> E{OUTB, D}; GEMM_PHASE(pg8::EpiGated<1>, E, HB, (const bf16*)(ws + WS_WGLU), MLAT, 4096, D); } SEAM(17);
    if (IN(18)) { thin_phase(C, 5, true, 1, 3, 5, 1.0f, true, 1, 4, 6, 7, 1, 1, MLAT, 0); } SEAM(18);
    if (IN(19)) { pg8::EpiGated<0> E{ACTB, FF}; GEMM_PHASE(pg8::EpiGated<0>, E, HB, WIN(3), MLAT, 2 * FF, D); } SEAM(19);
    if (IN(20)) { pg8::EpiPlain E{OUTB, D}; GEMM_PHASE_W(pg8::EpiPlain, E, ACTB, WOUT(3), MLAT, D, FF, 4 + 16); } SEAM(20);
    if (IN(21)) { thin_phase(C, 6, true, 1, 5, 8, 0.5f, false, 0, 0, 0, 0, 1, 2, MLAT, 0); }
#undef IN
#undef SEAM
}

extern "C" void kernel_launch(void* const* d_in, const int* in_sizes, int n_in, void* d_out, int out_size, void* d_ws, size_t ws_size, hipStream_t stream) {
    static int grid = 0;
    if (grid == 0) {
        if (n_in != 22 || out_size != MLAT * D || ws_size < WS_END) { fprintf(stderr, "kernel_launch: unexpected shapes (n_in %d, out %d, ws %zu)\n", n_in, out_size, ws_size); grid = -1; return; }
        int dev = 0, cus = 0, per_cu = 0;
        if (hipGetDevice(&dev) != hipSuccess || hipDeviceGetAttribute(&cus, hipDeviceAttributeMultiprocessorCount, dev) != hipSuccess) { grid = -1; return; }
        if (hipFuncSetAttribute((const void*)fwd_kernel, hipFuncAttributeMaxDynamicSharedMemorySize, LDS_BYTES) != hipSuccess) { fprintf(stderr, "kernel_launch: hipFuncSetAttribute failed\n"); grid = -1; return; }
        if (hipOccupancyMaxActiveBlocksPerMultiprocessor(&per_cu, (const void*)fwd_kernel, NWAVES * 64, LDS_BYTES) != hipSuccess || per_cu < 1) fprintf(stderr, "kernel_launch: occupancy query says %d\n", per_cu);
        (void)hipGetLastError();
        grid = cus;
    }
    if (grid < 0) return;
    (void)hipMemsetAsync((char*)d_ws + WS_CTL, 0, CTL_ZERO_BYTES, stream);
    Args a{};
    for (int i = 0; i < 22; ++i) a.in[i] = (const float*)d_in[i];
    a.out = (float*)d_out; a.ws = (unsigned char*)d_ws;
#if MK_ONE_LAUNCH
    a.ph_lo = 0; a.ph_hi = NPHASE;
    hipLaunchKernelGGL(fwd_kernel, dim3(grid), dim3(NWAVES * 64), LDS_BYTES, stream, a);
#else
    for (int p = 0; p < NPHASE; ++p) { a.ph_lo = p; a.ph_hi = p + 1; hipLaunchKernelGGL(fwd_kernel, dim3(grid), dim3(NWAVES * 64), LDS_BYTES, stream, a); }
#endif
}
```

```cpp
#include <hip/hip_runtime.h>
#include <cstdio>
#include <cstdint>
namespace pg8 {
#define PG8_LAS __attribute__((address_space(3)))
typedef unsigned short bf16_t;
typedef short bf16x8 __attribute__((ext_vector_type(8)));
typedef float f32x4 __attribute__((ext_vector_type(4)));
typedef unsigned u32x4 __attribute__((ext_vector_type(4)));
constexpr int BM = 256, BK = 64, HALF = 128, HTB = HALF * BK * 2  , STAGE_BYTES = 8 * HTB, NXCD = 8, WGM = 8;

__host__ __device__ __forceinline__ int lds_byte(int r, int c) { const int st = (r >> 4) * 2 + (c >> 5), rr = r & 15, cc = c & 31, ob = rr * 64 + cc * 2; return st * 1024 + (ob ^ (((ob >> 9) & 1) << 5)); }
__host__ __device__ __forceinline__ void stage_rc(int b, int& R, int& C) { const int st = b / 1024, sb = b % 1024, swz = sb ^ (((sb >> 9) & 1) << 5); R = (st >> 1) * 16 + swz / 64; C = (st & 1) * 32 + (swz % 64) / 2; }
__host__ __device__ __forceinline__ int perm32(int rho) { const int n = rho >> 4, i = rho & 15; return 8 * (i >> 2) + 4 * n + (i & 3); }

struct Unit { int pm, pn, ks; };
struct Gemm { const bf16_t* A; const bf16_t* Bt; int M, N, K, ld, kchunk; };

struct StaticOrder {
    int nM, nN, nwg, G, c, wgm, rev;
    __host__ __device__ void init(int M, int N, int G_, int c_, int wgm_ = WGM, int rev_ = 0) { nM = M / BM; nN = N / BM; nwg = nM * nN; G = G_; c = c_; wgm = wgm_; rev = rev_; }
    __host__ __device__ bool next(int i, Unit& u) const {
        const long L = (long)i * G + c; if (L >= nwg) return false;
        const int nMa = (nM / (wgm * NXCD)) * (wgm * NXCD), nwga = nMa * nN;
        if (nMa > 0 && nMa < nM) {
            if (L >= nwga) { const int e = (int)L - nwga, nMr = nM - nMa; u.pm = nMa + e % nMr; u.pn = e / nMr; u.ks = 0; return true; }
            int wgid = (int)L; { const int q = nwga / NXCD, xcd = wgid % NXCD; int off = wgid / NXCD; if (rev) off = q - 1 - off; wgid = xcd * q + off; }
            const int nig = wgm * nN, gid = wgid / nig, fm = gid * wgm;
            u.pm = fm + ((wgid % nig) % wgm); u.pn = (wgid % nig) / wgm; u.ks = 0; return true;
        }
        int wgid = (int)L; { const int q = nwg / NXCD, r = nwg % NXCD, xcd = wgid % NXCD; int off = wgid / NXCD; if (rev) off = (xcd < r ? q + 1 : q) - 1 - off; wgid = (xcd < r ? xcd * (q + 1) : r * (q + 1) + (xcd - r) * q) + off; }
        const int nig = wgm * nN, gid = wgid / nig, fm = gid * wgm, gsz = (nM - fm) < wgm ? (nM - fm) : wgm;
        u.pm = fm + ((wgid % nig) % gsz); u.pn = (wgid % nig) / gsz; u.ks = 0; return true;
    }
    __device__ __forceinline__ void a_ready(const Unit&) const {}
    __device__ __forceinline__ void done(const Unit&) const {}
};

struct SplitKOrder {
    int pm0, npm, nN, nks, G, c;
    __host__ __device__ void init(int pm0_, int npm_, int N, int nks_, int G_, int c_) { pm0 = pm0_; npm = npm_; nN = N / BM; nks = nks_; G = G_; c = c_; }
    __host__ __device__ bool next(int i, Unit& u) const {
        const int L = i * G + c; if (L >= npm * nN * nks) return false;
        u.ks = L % nks; const int t = L / nks; u.pn = t % nN; u.pm = pm0 + t / nN; return true;
    }
    __device__ __forceinline__ void a_ready(const Unit&) const {}
    __device__ __forceinline__ void done(const Unit&) const {}
};

__device__ __forceinline__ unsigned cvt_pk_bf16(float lo, float hi) { unsigned r; asm volatile("v_cvt_pk_bf16_f32 %0, %1, %2" : "=v"(r) : "v"(lo), "v"(hi)); return r; }

template <class Epi, class Sched, bool ALIGN_EPI = false, bool SP2 = false>
__device__ __forceinline__ void gemm_phase(PG8_LAS unsigned char* lds, const Gemm g, const Sched& S, const Epi& E) {
    const int tid = threadIdx.x, wid = __builtin_amdgcn_readfirstlane(tid >> 6), lane = tid & 63, wr = wid >> 2, wc = wid & 3, fr = lane & 15, fq = lane >> 4;
    const int K = g.ld, nt = g.K / BK; const size_t kcb = (size_t)g.kchunk * 2;
    unsigned voffA[2], voffB[2];
#pragma unroll
    for (int i = 0; i < 2; ++i) { int R, C; stage_rc(tid * 16 + i * 8192, R, C); const int Rb = Epi::PERM ? ((R & ~31) + perm32(R & 31)) : R;
        voffA[i] = (unsigned)(R * K + C) * 2u; voffB[i] = (unsigned)(Rb * K + C) * 2u; }
    const size_t kstep = (size_t)(BK * 2);
    const size_t hstep = (size_t)HALF * K * 2;
    const size_t tstep = 2 * hstep;
    const unsigned ldsw = (unsigned)wid * 1024u;
    const int aoff = lds_byte(wr * 64 + fr, fq * 8), boff = lds_byte(wc * 32 + fr, fq * 8);
#define PG8_SA(b, h) (((b) * 2 + (h)) * HTB)
#define PG8_SB(b, h) ((4 + (b) * 2 + (h)) * HTB)
#define PG8_STAGE(bufoff, gbase, voff) do { _Pragma("unroll") for (int _i = 0; _i < 2; ++_i) \
        __builtin_amdgcn_global_load_lds((const unsigned*)((const char*)(gbase) + (voff)[_i]), (PG8_LAS unsigned*)(lds + (bufoff) + ldsw + _i * 8192), 16, 0, 0); } while (0)
#define PG8_LDA(dst, b, h) do { _Pragma("unroll") for (int m = 0; m < 4; ++m) _Pragma("unroll") for (int k = 0; k < 2; ++k) dst[m][k] = *(const PG8_LAS bf16x8*)(lds + PG8_SA(b, h) + aoff + m * 2048 + k * 1024); } while (0)
#define PG8_LDB(dst, b, h) do { _Pragma("unroll") for (int n = 0; n < 2; ++n) _Pragma("unroll") for (int k = 0; k < 2; ++k) dst[n][k] = *(const PG8_LAS bf16x8*)(lds + PG8_SB(b, h) + boff + n * 2048 + k * 1024); } while (0)
#define PG8_MMA(ai, bj, At, Bt) do { __builtin_amdgcn_s_setprio(1); _Pragma("unroll") for (int m = 0; m < 4; ++m) _Pragma("unroll") for (int n = 0; n < 2; ++n) _Pragma("unroll") for (int k = 0; k < 2; ++k) \
        acc[ai][bj][m][n] = __builtin_amdgcn_mfma_f32_16x16x32_bf16(Bt[n][k], At[m][k], acc[ai][bj][m][n], 0, 0, 0); __builtin_amdgcn_s_setprio(0); } while (0)
#define PG8_WAIT_V(n) asm volatile("s_waitcnt vmcnt(" #n ")" ::: "memory")
#define PG8_WAIT_L(n) asm volatile("s_waitcnt lgkmcnt(" #n ")" ::: "memory")
#define PG8_BAR __builtin_amdgcn_s_barrier()
#define PG8_SCHED __builtin_amdgcn_sched_barrier(0)
    Unit cur, nxt; int ui = 0;
    if (!S.next(0, cur)) return;
    f32x4 acc[2][2][4][2];
#pragma unroll
    for (int a = 0; a < 2; ++a)
#pragma unroll
        for (int b = 0; b < 2; ++b)
#pragma unroll
            for (int m = 0; m < 4; ++m)
#pragma unroll
                for (int n = 0; n < 2; ++n) acc[a][b][m][n] = (f32x4){0.f, 0.f, 0.f, 0.f};
    bf16x8 At[4][2], B0[2][2], B1[2][2];
    const char* cA = (const char*)g.A + (size_t)cur.pm * tstep + (size_t)cur.ks * kcb; const char* cB = (const char*)g.Bt + (size_t)cur.pn * tstep + (size_t)cur.ks * kcb;
    S.a_ready(cur);
    if constexpr (SP2) {
        PG8_STAGE(PG8_SB(0, 0), cB, voffB); PG8_STAGE(PG8_SB(0, 1), cB + hstep, voffB); PG8_STAGE(PG8_SA(0, 0), cA, voffA); PG8_STAGE(PG8_SA(0, 1), cA + hstep, voffA);
        if (wr == 1) PG8_BAR;
        PG8_WAIT_V(2); PG8_BAR;
        PG8_STAGE(PG8_SB(1, 0), cB + kstep, voffB); PG8_STAGE(PG8_SA(1, 0), cA + kstep, voffA); PG8_STAGE(PG8_SB(1, 1), cB + hstep + kstep, voffB);
        PG8_WAIT_V(6); PG8_BAR;
    } else {
        PG8_STAGE(PG8_SB(0, 0), cB, voffB); PG8_STAGE(PG8_SA(0, 0), cA, voffA); PG8_STAGE(PG8_SB(0, 1), cB + hstep, voffB); PG8_STAGE(PG8_SA(0, 1), cA + hstep, voffA);
        if (wr == 1) PG8_BAR;
        PG8_WAIT_V(4); PG8_BAR;
        PG8_STAGE(PG8_SB(1, 0), cB + kstep, voffB); PG8_STAGE(PG8_SA(1, 0), cA + kstep, voffA); PG8_STAGE(PG8_SB(1, 1), cB + hstep + kstep, voffB);
        PG8_WAIT_V(6); PG8_BAR;
    }
    for (;;) {
        const bool has_next = S.next(ui + 1, nxt);
        const char* nA = has_next ? (const char*)g.A + (size_t)nxt.pm * tstep + (size_t)nxt.ks * kcb : cA; const char* nB = has_next ? (const char*)g.Bt + (size_t)nxt.pn * tstep + (size_t)nxt.ks * kcb : cB;
        for (int t = 0; t < nt; t += 2) {
            const bool last = (t == nt - 2);
            const char* a1 = cA + (size_t)(t + 1) * kstep;
            const char* a2 = last ? nA : cA + (size_t)(t + 2) * kstep; const char* b2 = last ? nB : cB + (size_t)(t + 2) * kstep;
            const char* a3 = a2 + kstep; const char* b3 = b2 + kstep;
            if (last && has_next) S.a_ready(nxt);
            if constexpr (SP2) {
            PG8_LDB(B0, 0, 0); PG8_LDB(B1, 0, 1); PG8_SCHED; PG8_LDA(At, 0, 0); PG8_STAGE(PG8_SA(1, 1), a1 + hstep, voffA);
            PG8_WAIT_V(8); PG8_WAIT_L(0); PG8_BAR; PG8_MMA(0, 0, At, B0); PG8_MMA(0, 1, At, B1); PG8_BAR; PG8_SCHED;
            PG8_LDA(At, 0, 1); PG8_STAGE(PG8_SB(0, 0), b2, voffB); PG8_STAGE(PG8_SB(0, 1), b2 + hstep, voffB); PG8_STAGE(PG8_SA(0, 0), a2, voffA);
            PG8_WAIT_V(8); PG8_WAIT_L(0); PG8_BAR; PG8_MMA(1, 0, At, B0); PG8_MMA(1, 1, At, B1); PG8_BAR; PG8_SCHED;
            PG8_LDB(B0, 1, 0); PG8_LDB(B1, 1, 1); PG8_SCHED; PG8_LDA(At, 1, 0); PG8_STAGE(PG8_SA(0, 1), a2 + hstep, voffA);
            PG8_WAIT_V(8); PG8_WAIT_L(0); PG8_BAR; PG8_MMA(0, 0, At, B0); PG8_MMA(0, 1, At, B1); PG8_BAR; PG8_SCHED;
            PG8_LDA(At, 1, 1); PG8_STAGE(PG8_SB(1, 0), b3, voffB); PG8_STAGE(PG8_SB(1, 1), b3 + hstep, voffB); PG8_STAGE(PG8_SA(1, 0), a3, voffA);
            PG8_WAIT_V(8); PG8_WAIT_L(0); PG8_BAR; PG8_MMA(1, 0, At, B0); PG8_MMA(1, 1, At, B1); PG8_BAR; PG8_SCHED;
            } else {
            PG8_LDB(B0, 0, 0); PG8_SCHED; PG8_LDA(At, 0, 0); PG8_STAGE(PG8_SA(1, 1), a1 + hstep, voffA);
            PG8_WAIT_L(8); PG8_BAR; PG8_WAIT_L(0); PG8_MMA(0, 0, At, B0); PG8_BAR; PG8_SCHED;
            PG8_LDB(B1, 0, 1); PG8_STAGE(PG8_SB(0, 0), b2, voffB);
            PG8_BAR; PG8_WAIT_L(0); PG8_MMA(0, 1, At, B1); PG8_BAR;
            PG8_LDA(At, 0, 1); PG8_STAGE(PG8_SA(0, 0), a2, voffA);
            PG8_BAR; PG8_WAIT_L(0); PG8_MMA(1, 0, At, B0); PG8_BAR; PG8_SCHED;
            PG8_STAGE(PG8_SB(0, 1), b2 + hstep, voffB);
            PG8_WAIT_V(6); PG8_BAR; PG8_MMA(1, 1, At, B1); PG8_BAR;
            PG8_LDB(B0, 1, 0); PG8_SCHED; PG8_LDA(At, 1, 0); PG8_STAGE(PG8_SA(0, 1), a2 + hstep, voffA);
            PG8_WAIT_L(8); PG8_BAR; PG8_WAIT_L(0); PG8_MMA(0, 0, At, B0); PG8_BAR; PG8_SCHED;
            PG8_LDB(B1, 1, 1); PG8_STAGE(PG8_SB(1, 0), b3, voffB);
            PG8_BAR; PG8_WAIT_L(0); PG8_MMA(0, 1, At, B1); PG8_BAR;
            PG8_LDA(At, 1, 1); PG8_STAGE(PG8_SA(1, 0), a3, voffA);
            PG8_BAR; PG8_WAIT_L(0); PG8_MMA(1, 0, At, B0); PG8_BAR; PG8_SCHED;
            PG8_STAGE(PG8_SB(1, 1), b3 + hstep, voffB);
            PG8_WAIT_V(6); PG8_BAR; PG8_MMA(1, 1, At, B1); PG8_BAR;
            }
        }
        if constexpr (ALIGN_EPI) { if (wr == 0) PG8_BAR; }
        if constexpr (!Epi::AFTER_DRAIN) { E(acc, cur, wr, wc, fr, fq); S.done(cur); }
        if (!has_next) break;
#pragma unroll
        for (int a = 0; a < 2; ++a)
#pragma unroll
            for (int b = 0; b < 2; ++b)
#pragma unroll
                for (int m = 0; m < 4; ++m)
#pragma unroll
                    for (int n = 0; n < 2; ++n) acc[a][b][m][n] = (f32x4){0.f, 0.f, 0.f, 0.f};
        cur = nxt; cA = nA; cB = nB; ++ui;
        if constexpr (ALIGN_EPI) { if (wr == 1) PG8_BAR; }
    }
    PG8_WAIT_V(0);
    if constexpr (!ALIGN_EPI) { if (wr == 0) PG8_BAR; }
    PG8_BAR;
    if constexpr (Epi::AFTER_DRAIN) { E.fused(acc, cur, wr, wc, fr, fq, lds, wid, lane); S.done(cur); }
#undef PG8_SA
#undef PG8_SB
#undef PG8_STAGE
#undef PG8_LDA
#undef PG8_LDB
#undef PG8_MMA
#undef PG8_WAIT_V
#undef PG8_WAIT_L
#undef PG8_BAR
#undef PG8_SCHED
}
}
#define GAS __attribute__((address_space(1)))
#define LAS __attribute__((address_space(3)))
typedef unsigned short bf16;
typedef unsigned v4u __attribute__((ext_vector_type(4)));
typedef float f32x4 __attribute__((ext_vector_type(4)));
typedef short bf16x8 __attribute__((ext_vector_type(8)));
typedef GAS unsigned gu32;
typedef GAS unsigned long long gu64;
#define RLX_AGENT __ATOMIC_RELAXED, __HIP_MEMORY_SCOPE_AGENT
#define LDS_WAIT() asm volatile("s_waitcnt lgkmcnt(0)" ::: "memory")
#define VM_WAIT() asm volatile("s_waitcnt vmcnt(0)" ::: "memory")
__device__ __forceinline__ unsigned long long rt() { return __builtin_amdgcn_s_memrealtime(); }
__device__ __forceinline__ unsigned f2bf(float f) { unsigned u = __builtin_bit_cast(unsigned, f); return (u + 0x7fffu + ((u >> 16) & 1u)) >> 16; }
__device__ __forceinline__ unsigned pk2(float lo, float hi) { return f2bf(lo) | (f2bf(hi) << 16); }

#define XB_TMO      128
#define XB_XCNT(j)  (256  + 64 * (j))
#define XB_XSUB(j)  (1280 + 64 * (j))
#define XB_XGEN(j)  (2304 + 64 * (j))
#define XB_TOP      3328
#define XB_TOPGEN   3392
#define XCD_BAR_WORDS 3456
#define XB_SPIN_CAP (1u << 18)

__device__ __forceinline__ unsigned xb_ld(unsigned* p)              { return __hip_atomic_load(p, __ATOMIC_RELAXED, __HIP_MEMORY_SCOPE_AGENT); }
__device__ __forceinline__ unsigned xb_add(unsigned* p, unsigned v) { return __hip_atomic_fetch_add(p, v, __ATOMIC_RELAXED, __HIP_MEMORY_SCOPE_AGENT); }
__device__ __forceinline__ unsigned xb_xcc_id() { return (unsigned)__builtin_amdgcn_s_getreg((3 << 11) | 20) & 0xFu; }
#define XB_SPIN(cond, bar) do { unsigned _sp = 0; while (cond) { __builtin_amdgcn_s_sleep(1); \
    if ((++_sp & 255u) == 0u) { if (xb_ld(&(bar)[XB_TMO])) break; if (_sp > XB_SPIN_CAP) { atomicAdd(&(bar)[XB_TMO], 1u); break; } } } } while (0)

struct XcdBarrier {
    unsigned* bar; unsigned x;
    volatile LAS unsigned* st;
};

__device__ __forceinline__ XcdBarrier xcd_barrier_post(unsigned* bar, volatile LAS unsigned* st) {
    XcdBarrier b; b.bar = bar; b.x = xb_xcc_id(); b.st = st;
    if (threadIdx.x == 0) (void)xb_add(&bar[XB_XCNT(b.x)], 1u);
    return b;
}
__device__ __forceinline__ void xcd_barrier_complete(unsigned* bar, unsigned x, unsigned& nloc, unsigned& nx) {
    const unsigned G = gridDim.x * gridDim.y * gridDim.z;
    unsigned sum, cnt, mine, sp = 0u;
    for (;;) {
        sum = 0u; cnt = 0u; mine = 0u;
#pragma unroll
        for (unsigned j = 0; j < 16; ++j) { const unsigned c = xb_ld(&bar[XB_XCNT(j)]); sum += c; cnt += (c > 0u) ? 1u : 0u; mine = (j == x) ? c : mine; }
        if (sum == G) break;
        __builtin_amdgcn_s_sleep(1);
        if ((++sp & 255u) == 0u) { if (xb_ld(&bar[XB_TMO])) break; if (sp > XB_SPIN_CAP) { atomicAdd(&bar[XB_TMO], 1u); break; } }
    }
    nloc = mine > 0u ? mine : 1u; nx = cnt > 0u ? cnt : 1u;
}

__device__ __forceinline__ void xcd_barrier(const XcdBarrier& b) {
    asm volatile("s_waitcnt vmcnt(0)" ::: "memory");
    __syncthreads();
    if (threadIdx.x == 0) {
        unsigned* bar = b.bar;
        __builtin_amdgcn_s_waitcnt(0);
        unsigned nloc = b.st[0], nx = b.st[1];
        if (nloc == 0u) { xcd_barrier_complete(bar, b.x, nloc, nx); b.st[0] = nloc; b.st[1] = nx; }
        const unsigned old = xb_add(&bar[XB_XSUB(b.x)], 1u);
        const unsigned gen = old / nloc;
        if (old + 1u == (gen + 1u) * nloc) {
            __builtin_amdgcn_fence(__ATOMIC_RELEASE, "agent");
            asm volatile("s_waitcnt vmcnt(0)" ::: "memory");
            const unsigned og = xb_add(&bar[XB_TOP], 1u);
            const unsigned tg = og / nx;
            if (og + 1u == (tg + 1u) * nx) xb_add(&bar[XB_TOPGEN], 1u);
            else XB_SPIN(xb_ld(&bar[XB_TOPGEN]) == tg, bar);
            __builtin_amdgcn_fence(__ATOMIC_ACQUIRE, "agent");
            xb_add(&bar[XB_XGEN(b.x)], 1u);
            asm volatile("s_waitcnt vmcnt(0)" ::: "memory");
        } else {
            XB_SPIN(xb_ld(&bar[XB_XGEN(b.x)]) == gen, bar);
            __builtin_amdgcn_fence(__ATOMIC_ACQUIRE, "agent");
            asm volatile("s_waitcnt vmcnt(0)" ::: "memory");
        }
    }
    __syncthreads();
}

constexpr int D = 2048, SEQ = 16384, NB = 2, CTXL = 256, FF = 5632;
constexpr int MLAT = NB * SEQ;
constexpr int MCTX = NB * CTXL;
constexpr int MALL = MLAT + MCTX;
constexpr int NMOD = 9 * D;
constexpr int KVD = 512;
constexpr float EPSN = 1e-6f;
constexpr int NWAVES = 8;

constexpr size_t MiB = 1u << 20;
constexpr size_t WS_CTL = 0, CTL_ZERO_BYTES = 2 * MiB;
constexpr size_t WS_MODS = 1 * MiB;
constexpr size_t WS_ROPE = 2 * MiB;
constexpr size_t WS_XCTX = 10 * MiB;
constexpr size_t WS_WIN = 16 * MiB, WIN_STRIDE = 44 * MiB;
constexpr size_t WS_WOUT = 192 * MiB, WOUT_STRIDE = 22 * MiB;
constexpr size_t WS_WQKV = 280 * MiB, WS_WO = 292 * MiB, WS_WSIN = 300 * MiB, WS_WGLU = 308 * MiB;
constexpr size_t WS_H = 324 * MiB;
constexpr size_t WS_OUT = 454 * MiB;
constexpr size_t WS_ACT = 584 * MiB;
constexpr size_t WS_Q = 942 * MiB, WS_K = 1072 * MiB, WS_V = 1105 * MiB;
constexpr size_t WS_U = 942 * MiB;
constexpr size_t WS_XB = 1138 * MiB;
constexpr size_t WS_Y = 584 * MiB;
constexpr size_t WS_PART = 1268 * MiB;
constexpr size_t WS_MODP = 1312 * MiB;
constexpr size_t WS_END = 1320 * MiB;
constexpr int CW_BAR = 4096;

constexpr int LDS_BYTES = 163840;
constexpr int MISC_OFF = 163840 - 256;

template <int CTRL> __device__ __forceinline__ float dppmov(float v) { return __int_as_float(__builtin_amdgcn_update_dpp(0, __float_as_int(v), CTRL, 0xf, 0xf, true)); }
__device__ __forceinline__ float wave_sum(float v) {
    v += dppmov<0xB1>(v);
    v += dppmov<0x4E>(v);
    v += dppmov<0x141>(v);
    v += dppmov<0x140>(v);
    v += __shfl_xor(v, 16);
    v += __shfl_xor(v, 32);
    return v;
}
__device__ __forceinline__ float wave_max(float v) {
#pragma unroll
    for (int o = 1; o < 64; o <<= 1) v = fmaxf(v, __shfl_xor(v, o));
    return v;
}
typedef unsigned tu32x2 __attribute__((ext_vector_type(2)));
typedef float tf32x2 __attribute__((ext_vector_type(2))); typedef __bf16 tbf16x2 __attribute__((ext_vector_type(2)));
__device__ __forceinline__ unsigned cvt2bf(float lo, float hi) { tf32x2 v = {lo, hi}; tbf16x2 b = __builtin_convertvector(v, tbf16x2); return __builtin_bit_cast(unsigned, b); }
__device__ __forceinline__ float bflo(unsigned w) { return __uint_as_float(w << 16); }
__device__ __forceinline__ float bfhi(unsigned w) { return __uint_as_float(w & 0xffff0000u); }

namespace pg8 {
struct EpiPartial {
    static constexpr bool PERM = false, AFTER_DRAIN = false;
    float* P; int ldc; int row_base; size_t slab;
    __device__ __forceinline__ void operator()(const f32x4 (&acc)[2][2][4][2], const Unit& u, int wr, int wc, int fr, int fq) const {
        const int row0 = u.pm * BM - row_base + wr * 64 + fr, col0 = u.pn * BM + wc * 32 + 4 * fq;
        float* base = P + (size_t)u.ks * slab;
#pragma unroll
        for (int ai = 0; ai < 2; ++ai)
#pragma unroll
            for (int m = 0; m < 4; ++m) { float* rowp = base + (size_t)(row0 + ai * HALF + m * 16) * ldc + col0;
#pragma unroll
                for (int bj = 0; bj < 2; ++bj)
#pragma unroll
                    for (int n = 0; n < 2; ++n) *(f32x4*)(rowp + bj * HALF + n * 16) = acc[ai][bj][m][n]; }
    }
};
struct EpiPlain {
    static constexpr bool PERM = true, AFTER_DRAIN = false;
    bf16_t* O; int ldc;
    __device__ __forceinline__ void operator()(const f32x4 (&acc)[2][2][4][2], const Unit& u, int wr, int wc, int fr, int fq) const {
        const int row0 = u.pm * BM + wr * 64 + fr, col0 = u.pn * BM + wc * 32 + 8 * fq;
#pragma unroll
        for (int ai = 0; ai < 2; ++ai)
#pragma unroll
            for (int m = 0; m < 4; ++m) { bf16_t* rowp = O + (size_t)(row0 + ai * HALF + m * 16) * ldc + col0;
#pragma unroll
                for (int bj = 0; bj < 2; ++bj) { const f32x4 v0 = acc[ai][bj][m][0], v1 = acc[ai][bj][m][1];
                    u32x4 w; w.x = cvt_pk_bf16(v0[0], v0[1]); w.y = cvt_pk_bf16(v0[2], v0[3]); w.z = cvt_pk_bf16(v1[0], v1[1]); w.w = cvt_pk_bf16(v1[2], v1[3]);
                    *(u32x4*)(rowp + bj * HALF) = w; } }
    }
};
template <int MODE> struct EpiGated {
    static constexpr bool PERM = true, AFTER_DRAIN = false;
    bf16_t* O; int ldc;
    __device__ __forceinline__ void operator()(const f32x4 (&acc)[2][2][4][2], const Unit& u, int wr, int wc, int fr, int fq) const {
        const int row0 = u.pm * BM + wr * 64 + fr, col0 = u.pn * (BM / 2) + wc * 16 + 4 * (fq & ~1);
#pragma unroll
        for (int ai = 0; ai < 2; ++ai)
#pragma unroll
            for (int mp = 0; mp < 2; ++mp) {
                bf16_t* rowp = O + (size_t)(row0 + ai * HALF + (2 * mp + (fq & 1)) * 16) * ldc + col0;
#pragma unroll
                for (int bj = 0; bj < 2; ++bj) {
                    unsigned pw[2][2];
#pragma unroll
                    for (int mm = 0; mm < 2; ++mm) { const f32x4 v0 = acc[ai][bj][2 * mp + mm][0], v1 = acc[ai][bj][2 * mp + mm][1]; float r[4];
#pragma unroll
                        for (int e = 0; e < 4; ++e) {
                            if (MODE == 0) r[e] = v0[e] * __builtin_amdgcn_rcpf(1.0f + __expf(-v0[e])) * v1[e];
                            else           r[e] = v0[e] * __builtin_amdgcn_rcpf(1.0f + __expf(-v1[e])); }
                        pw[mm][0] = cvt_pk_bf16(r[0], r[1]); pw[mm][1] = cvt_pk_bf16(r[2], r[3]); }
                    const auto sx = __builtin_amdgcn_permlane16_swap(pw[0][0], pw[1][0], false, false);
                    const auto sy = __builtin_amdgcn_permlane16_swap(pw[0][1], pw[1][1], false, false);
                    u32x4 w; w.x = sx[0]; w.y = sy[0]; w.z = sx[1]; w.w = sy[1];
                    *(u32x4*)(rowp + bj * (HALF / 2)) = w; } }
    }
};
struct EpiQKV {
    static constexpr bool PERM = true, AFTER_DRAIN = false;
    bf16_t* Q; bf16_t* K; bf16_t* V; const float* rope; float qscale;
    __device__ __forceinline__ void operator()(const f32x4 (&acc)[2][2][4][2], const Unit& u, int wr, int wc, int fr, int fq) const {
        const int row0 = u.pm * BM + wr * 64 + fr; const int pn = u.pn;
        if (pn >= 10) {
            const int col0 = (pn - 10) * BM + wc * 32 + 8 * fq;
#pragma unroll
            for (int ai = 0; ai < 2; ++ai)
#pragma unroll
                for (int m = 0; m < 4; ++m) { bf16_t* rowp = V + (size_t)(row0 + ai * HALF + m * 16) * KVD + col0;
#pragma unroll
                    for (int bj = 0; bj < 2; ++bj) { const f32x4 v0 = acc[ai][bj][m][0], v1 = acc[ai][bj][m][1];
                        u32x4 w; w.x = cvt_pk_bf16(v0[0], v0[1]); w.y = cvt_pk_bf16(v0[2], v0[3]); w.z = cvt_pk_bf16(v1[0], v1[1]); w.w = cvt_pk_bf16(v1[2], v1[3]);
                        *(u32x4*)(rowp + bj * HALF) = w; } }
            return;
        }
        const bool isq = pn < 8; const bool lat = u.pm < (MLAT / BM);
        const float sc = isq ? qscale : 1.0f;
        const int tcol = (wc >> 1) * 32 + 16 * (wc & 1) + 4 * fq;
#pragma unroll
        for (int ai = 0; ai < 2; ++ai)
#pragma unroll
            for (int m = 0; m < 4; ++m) {
                const int row = row0 + ai * HALF + m * 16;
                f32x4 t0 = (f32x4){1.f, 0.f, 1.f, 0.f}, t1 = (f32x4){1.f, 0.f, 1.f, 0.f};
                if (lat) { const f32x4* tp = (const f32x4*)(rope + ((size_t)(row & (SEQ - 1)) * 64 + tcol) * 2); t0 = tp[0]; t1 = tp[1]; }
#pragma unroll
                for (int bj = 0; bj < 2; ++bj) { const f32x4 v0 = acc[ai][bj][m][0], v1 = acc[ai][bj][m][1];
                    const float a0 = (v0[0] * t0[0] - v0[1] * t0[1]) * sc, a1 = (v0[1] * t0[0] + v0[0] * t0[1]) * sc;
                    const float a2 = (v0[2] * t0[2] - v0[3] * t0[3]) * sc, a3 = (v0[3] * t0[2] + v0[2] * t0[3]) * sc;
                    const float b0 = (v1[0] * t1[0] - v1[1] * t1[1]) * sc, b1 = (v1[1] * t1[0] + v1[0] * t1[1]) * sc;
                    const float b2 = (v1[2] * t1[2] - v1[3] * t1[3]) * sc, b3 = (v1[3] * t1[2] + v1[2] * t1[3]) * sc;
                    u32x4 w; w.x = cvt_pk_bf16(a0, a1); w.y = cvt_pk_bf16(a2, a3); w.z = cvt_pk_bf16(b0, b1); w.w = cvt_pk_bf16(b2, b3);
                    bf16_t* dst = isq ? Q + (size_t)row * D + (pn * 2 + bj) * 128 + wc * 32 + 8 * fq
                                      : K + (size_t)row * KVD + ((pn - 8) * 2 + bj) * 128 + wc * 32 + 8 * fq;
                    *(u32x4*)dst = w; } }
    }
};
struct EpiUg {
    static constexpr bool PERM = true, AFTER_DRAIN = false;
    bf16_t* Ug;
    __device__ __forceinline__ void operator()(const f32x4 (&acc)[2][2][4][2], const Unit& u, int wr, int wc, int fr, int fq) const {
        const int b = u.pm < (MLAT / BM) ? (u.pm >> 6) : (u.pm - MLAT / BM);
        const int tok0 = u.pm < (MLAT / BM) ? CTXL + (u.pm & 63) * BM : 0;
#pragma unroll
        for (int ai = 0; ai < 2; ++ai)
#pragma unroll
            for (int m = 0; m < 4; ++m) { const int tok = tok0 + ai * HALF + wr * 64 + m * 16 + fr;
#pragma unroll
                for (int bj = 0; bj < 2; ++bj) { const f32x4 v0 = acc[ai][bj][m][0], v1 = acc[ai][bj][m][1];
                    const int g = 16 * u.pn + 8 * bj + 2 * wc + (fq >> 1);
                    u32x4 w; w.x = cvt_pk_bf16(v0[0], v0[1]); w.y = cvt_pk_bf16(v0[2], v0[3]); w.z = cvt_pk_bf16(v1[0], v1[1]); w.w = cvt_pk_bf16(v1[2], v1[3]);
                    *(u32x4*)(Ug + ((size_t)(b * 128 + g) * (CTXL + SEQ) + tok) * 16 + (fq & 1) * 8) = w; } }
    }
};
}

struct Args { const float* in[22]; float* out; unsigned char* ws; int ph_lo, ph_hi; };
struct Ctx {
    LAS unsigned char* lds;
    int tid, lane, wave, G, gw, NGW;
    const float* const* in;
    float* out; unsigned char* ws;
};

__device__ __forceinline__ int map_row(int mode, int n, int N) {
    if (mode == 1) { const int half = N >> 1; const int hi = n >= half ? 1 : 0; const int j = n - hi * half; return ((j >> 2) << 3) + hi * 4 + (j & 3); }
    if (mode == 2) { if (n >= 2560) return n; const int head = n >> 7, d = n & 127, a = d >> 6, dd = d & 63, which = dd >> 5, i = dd & 31; return (head << 7) + (a << 6) + 2 * i + which; }
    return n;
}
__device__ __forceinline__ void transpose_item(const float* W, int K, int N, bf16* WT, int mode, LAS float* scr, int item, int lane) {
    const int nblk = N / 32, kb = item / nblk, nb = item % nblk, k0 = 64 * kb, n0 = 32 * nb;
    float v[32];
#pragma unroll
    for (int i = 0; i < 32; ++i) v[i] = __builtin_nontemporal_load(W + (size_t)(k0 + 2 * i + (lane >> 5)) * N + n0 + (lane & 31));
#pragma unroll
    for (int i = 0; i < 32; ++i) scr[(2 * i + (lane >> 5)) * 33 + (lane & 31)] = v[i];
    LDS_WAIT(); asm volatile("" ::: "memory");
    const int c = lane & 7;
#pragma unroll
    for (int j = 0; j < 4; ++j) { const int n = (lane >> 3) + 8 * j; const LAS float* s = scr + (8 * c) * 33 + n;
        v4u o; o.x = cvt2bf(s[0 * 33], s[1 * 33]); o.y = cvt2bf(s[2 * 33], s[3 * 33]); o.z = cvt2bf(s[4 * 33], s[5 * 33]); o.w = cvt2bf(s[6 * 33], s[7 * 33]);
        *(v4u*)(WT + (size_t)map_row(mode, n0 + n, N) * K + k0 + 8 * c) = o; }
    LDS_WAIT(); asm volatile("" ::: "memory");
}
__device__ __forceinline__ float siluf(float x) { return x / (1.0f + __expf(-x)); }

constexpr int I_WIN = (D / 64) * (2 * FF / 32), I_WOUT = (FF / 64) * (D / 32), I_QKV = (D / 64) * (3072 / 32), I_SQ = (D / 64) * (D / 32), I_GLU = (D / 64) * (4096 / 32);
constexpr int CV_WIN0 = 0, CV_WOUT0 = CV_WIN0 + I_WIN, CV_WQKV = CV_WOUT0 + I_WOUT, CV_WO = CV_WQKV + I_QKV, CV_WIN1 = CV_WO + I_SQ, CV_WOUT1 = CV_WIN1 + I_WIN, CV_WIN2 = CV_WOUT1 + I_WOUT,
              CV_WOUT2 = CV_WIN2 + I_WIN, CV_WSIN = CV_WOUT2 + I_WOUT, CV_WGLU = CV_WSIN + I_SQ, CV_WIN3 = CV_WGLU + I_GLU, CV_WOUT3 = CV_WIN3 + I_WIN, CV_END = CV_WOUT3 + I_WOUT;
static_assert(CV_END == 78848, "item count");
constexpr int CV_S2_B = CV_WOUT0, CV_S2_E = CV_WIN1;
constexpr int CV_S5_B = CV_WIN1, CV_S5_E = CV_WIN1 + 14848;
constexpr int CV_S9_B = CV_S5_E, CV_S9_E = CV_S5_E + 10752;
constexpr int CV_P0B_B = CV_S9_E, CV_P0B_E = CV_WOUT2;
constexpr int CV_S12_B = CV_WOUT2, CV_S12_E = CV_WOUT2 + 10752;
constexpr int CV_S15_B = CV_S12_E, CV_S15_E = CV_S12_E + 14848;
constexpr int CV_P0C_B = CV_S15_E, CV_P0C_E = CV_END;
static_assert(CV_S5_E <= CV_WIN2 && CV_S9_E <= CV_WOUT2 && CV_S9_E >= CV_WIN2 && CV_S12_E <= CV_WIN3 && CV_S12_E >= CV_WGLU && CV_S15_E <= CV_END && CV_S15_E >= CV_WOUT3, "slot map");
__device__ __forceinline__ void convert_items(const Ctx& C, const int begin, const int end, const int rank, const int nranks) {
    LAS float* scr = (LAS float*)(C.lds + C.wave * 16384);
    for (int it = begin + rank * NWAVES + C.wave; it < end; it += nranks * NWAVES) {
        int r = it; const float* W; int K, N, mode; bf16* WT;
        if (r < CV_WOUT0) { W = C.in[7]; K = D; N = 2 * FF; mode = 1; WT = (bf16*)(C.ws + WS_WIN); }
        else if (r < CV_WQKV) { r -= CV_WOUT0; W = C.in[8]; K = FF; N = D; mode = 0; WT = (bf16*)(C.ws + WS_WOUT); }
        else if (r < CV_WO) { r -= CV_WQKV; W = C.in[9]; K = D; N = 3072; mode = 2; WT = (bf16*)(C.ws + WS_WQKV); }
        else if (r < CV_WIN1) { r -= CV_WO; W = C.in[10]; K = D; N = D; mode = 0; WT = (bf16*)(C.ws + WS_WO); }
        else if (r < CV_WOUT1) { r -= CV_WIN1; W = C.in[7] + (size_t)1 * D * 2 * FF; K = D; N = 2 * FF; mode = 1; WT = (bf16*)(C.ws + WS_WIN + 1 * WIN_STRIDE); }
        else if (r < CV_WIN2) { r -= CV_WOUT1; W = C.in[8] + (size_t)1 * FF * D; K = FF; N = D; mode = 0; WT = (bf16*)(C.ws + WS_WOUT + 1 * WOUT_STRIDE); }
        else if (r < CV_WOUT2) { r -= CV_WIN2; W = C.in[7] + (size_t)2 * D * 2 * FF; K = D; N = 2 * FF; mode = 1; WT = (bf16*)(C.ws + WS_WIN + 2 * WIN_STRIDE); }
        else if (r < CV_WSIN) { r -= CV_WOUT2; W = C.in[8] + (size_t)2 * FF * D; K = FF; N = D; mode = 0; WT = (bf16*)(C.ws + WS_WOUT + 2 * WOUT_STRIDE); }
        else if (r < CV_WGLU) { r -= CV_WSIN; W = C.in[12]; K = D; N = D; mode = 0; WT = (bf16*)(C.ws + WS_WSIN); }
        else if (r < CV_WIN3) { r -= CV_WGLU; W = C.in[21]; K = D; N = 4096; mode = 1; WT = (bf16*)(C.ws + WS_WGLU); }
        else if (r < CV_WOUT3) { r -= CV_WIN3; W = C.in[7] + (size_t)3 * D * 2 * FF; K = D; N = 2 * FF; mode = 1; WT = (bf16*)(C.ws + WS_WIN + 3 * WIN_STRIDE); }
        else { r -= CV_WOUT3; W = C.in[8] + (size_t)3 * FF * D; K = FF; N = D; mode = 0; WT = (bf16*)(C.ws + WS_WOUT + 3 * WOUT_STRIDE); }
        transpose_item(W, K, N, WT, mode, scr, r, C.lane);
    }
}
__device__ __forceinline__ void filler_convert(const Ctx& C, const int begin, const int end, const int nrem) {
    const int c = (int)blockIdx.x;
    if (c >= nrem && C.G > nrem) convert_items(C, begin, end, c - nrem, C.G - nrem);
    else if (C.G <= nrem) convert_items(C, begin, end, c, C.G);
}
__device__ __forceinline__ void p0_prologue(const Ctx& C) {
    const int lane = C.lane;
    convert_items(C, CV_WIN0, CV_WOUT0, (int)blockIdx.x, C.G);
    convert_items(C, CV_P0B_B, CV_P0B_E, (int)blockIdx.x, C.G);
    convert_items(C, CV_P0C_B, CV_P0C_E, (int)blockIdx.x, C.G);
    {
        float* modp = (float*)(C.ws + WS_MODP);
        const float* cvec = C.in[1]; const float* cctx = C.in[3]; const float* adaw = C.in[4];
        for (int it = C.gw; it < 2 * 72 * 16; it += C.NGW) {
            const int l = it / 1152, r = it % 1152, jb = r / 16, ks = r % 16, j0 = jb * 256 + lane * 4, k0 = ks * 128;
            const float sa0 = siluf(cvec[k0 + lane]), sb0 = siluf(cvec[k0 + 64 + lane]);
            const float sa1 = siluf(cvec[D + k0 + lane]), sb1 = siluf(cvec[D + k0 + 64 + lane]);
            const float sa2 = siluf(cctx[k0 + lane]), sb2 = siluf(cctx[k0 + 64 + lane]);
            f32x4 a0 = (f32x4){0.f, 0.f, 0.f, 0.f}, a1 = a0, a2 = a0;
            const float* wp = adaw + ((size_t)l * D + k0) * NMOD + j0;
#pragma unroll 16
            for (int kk = 0; kk < 64; ++kk) { const f32x4 w = __builtin_nontemporal_load((const f32x4*)(wp + (size_t)kk * NMOD));
                const float s0 = __shfl(sa0, kk), s1 = __shfl(sa1, kk), s2 = __shfl(sa2, kk);
                a0 += w * s0; a1 += w * s1; a2 += w * s2; }
#pragma unroll 16
            for (int kk = 0; kk < 64; ++kk) { const f32x4 w = __builtin_nontemporal_load((const f32x4*)(wp + (size_t)(64 + kk) * NMOD));
                const float s0 = __shfl(sb0, kk), s1 = __shfl(sb1, kk), s2 = __shfl(sb2, kk);
                a0 += w * s0; a1 += w * s1; a2 += w * s2; }
            float* m0 = modp + ((size_t)(ks * 2 + l) * 3) * NMOD + j0;
            *(f32x4*)m0 = a0; *(f32x4*)(m0 + NMOD) = a1; *(f32x4*)(m0 + 2 * NMOD) = a2;
        }
    }
    {
        float* rope = (float*)(C.ws + WS_ROPE);
        for (int idx = C.gw * 64 + lane; idx < SEQ * 64; idx += C.NGW * 64) {
            const int t = idx >> 6, a = (idx >> 5) & 1, i = idx & 31;
            const float pos = (float)(a ? (t & 63) : (t >> 6));
            const float invf = powf(10000.0f, -(float)(2 * i) / 64.0f);
            const float ang = pos * invf; float sn, cs; sincosf(ang, &sn, &cs);
            *(float2*)(rope + (size_t)idx * 2) = make_float2(cs, sn);
        }
    }
}

__device__ __forceinline__ float mod_value(const float* modp, const float* adab, int l, int v, int j) {
    float acc = adab[l * NMOD + j]; const size_t i = (size_t)(l * 3 + v) * NMOD + j;
#pragma unroll
    for (int ks = 0; ks < 16; ++ks) acc += modp[(size_t)ks * (2 * 3 * NMOD) + i];
    return acc;
}
__device__ __forceinline__ void tv_build(const Ctx& C) {
    float* TV = (float*)(C.ws + WS_XCTX); const float* modp = (const float*)(C.ws + WS_MODP); const float* adab = C.in[5]; const float* ng = C.in[6];
    for (int e = C.gw * 64 + C.lane; e < 7 * 3 * D; e += C.NGW * 64) {
        const int cfg = e / (3 * D), v = (e / D) % 3, col = e % D;
        const bool has_post = cfg != 0, has_pre = cfg != 6;
        const int lpost = cfg <= 3 ? 0 : 1, k3 = cfg == 0 ? 0 : (cfg - 1) % 3;
        const int gpost = 2 * k3 + 1, igate = 3 * k3 + 2; const float wgt = k3 == 1 ? 1.0f : 0.5f;
        const int lpre = cfg <= 2 ? 0 : 1, p3 = cfg % 3;
        const int gpre = 2 * p3, ishift = 3 * p3, iscale = 3 * p3 + 1;
        float A = 0.f, B = 0.f, Cc = 0.f;
        if (has_post) A = wgt * mod_value(modp, adab, lpost, v, igate * D + col) * ng[(lpost * 6 + gpost) * D + col];
        if (has_pre) { B = ng[(lpre * 6 + gpre) * D + col] * (1.0f + mod_value(modp, adab, lpre, v, iscale * D + col)); Cc = mod_value(modp, adab, lpre, v, ishift * D + col); }
        float* t = TV + ((size_t)(cfg * 3 + v) * 3) * D + col;
        t[0] = A; t[D] = B; t[2 * D] = Cc;
    }
}

__device__ __forceinline__ void thin_phase(const Ctx& C, const int cfg, bool has_post, int lpost, int gpost, int igate, float wgt,
                                           bool has_pre, int lpre, int gpre, int ishift, int iscale,
                                           const int srck, const int dstk, int nrows, int npart) {
    LAS float* vec = (LAS float*)C.lds;
    { const f32x4* tv = (const f32x4*)((const float*)(C.ws + WS_XCTX) + (size_t)cfg * 9 * D);
#pragma unroll
      for (int i = 0; i < 9; ++i) ((LAS f32x4*)vec)[C.tid + 512 * i] = tv[C.tid + 512 * i]; }
    __syncthreads();
    const bf16* OUTB = (const bf16*)(C.ws + WS_OUT); bf16* HB = (bf16*)(C.ws + WS_H); bf16* XBB = (bf16*)(C.ws + WS_XB);
    const int lane = C.lane;
    for (int row = C.gw; row < nrows; row += C.NGW) {
        const bool lat = row < MLAT; const int v = lat ? (row >> 14) : 2;

        const LAS f32x4* vA = (const LAS f32x4*)(vec + (v * 3 + 0) * D) + lane;
        const LAS f32x4* vB = (const LAS f32x4*)(vec + (v * 3 + 1) * D) + lane;
        const LAS f32x4* vC = (const LAS f32x4*)(vec + (v * 3 + 2) * D) + lane;
        f32x4 x[8];
        if (srck == 0) { const float* xs = lat ? C.in[0] + (size_t)row * D : C.in[2] + (size_t)(row - MLAT) * D;
#pragma unroll
            for (int j = 0; j < 8; ++j) x[j] = __builtin_nontemporal_load((const f32x4*)xs + lane + 64 * j); }
        else { const uint2* xp = (const uint2*)(XBB + (size_t)row * D) + lane;
#pragma unroll
            for (int j = 0; j < 8; ++j) { const tu32x2 w = __builtin_nontemporal_load((const tu32x2*)xp + 64 * j); x[j] = (f32x4){bflo(w.x), bfhi(w.x), bflo(w.y), bfhi(w.y)}; } }
        if (has_post) {
            f32x4 o[8]; float ss = 0.f;
            if (lat || npart == 0) { const uint2* op = (const uint2*)(OUTB + (size_t)row * D) + lane;
#pragma unroll
                for (int j = 0; j < 8; ++j) { const tu32x2 w = __builtin_nontemporal_load((const tu32x2*)op + 64 * j); o[j] = (f32x4){bflo(w.x), bfhi(w.x), bflo(w.y), bfhi(w.y)}; } }
            else { const f32x4* pp = (const f32x4*)((const float*)(C.ws + WS_PART) + (size_t)(row - MLAT) * D) + lane;
#pragma unroll
                for (int j = 0; j < 8; ++j) o[j] = pp[64 * j];
#pragma unroll 1
                for (int ks = 1; ks < npart; ++ks) { const f32x4* pk = pp + (size_t)ks * MCTX * D / 4;
#pragma unroll
                    for (int j = 0; j < 8; ++j) o[j] += pk[64 * j]; } }
#pragma unroll
            for (int j = 0; j < 8; ++j) ss += (o[j][0] * o[j][0] + o[j][1] * o[j][1]) + (o[j][2] * o[j][2] + o[j][3] * o[j][3]);
            const float rstd = rsqrtf(wave_sum(ss) * (1.0f / D) + EPSN);
#pragma unroll
            for (int j = 0; j < 8; ++j) x[j] += vA[64 * j] * (o[j] * rstd);
        }
        if (dstk == 1) { uint2* xq = (uint2*)(XBB + (size_t)row * D) + lane;
#pragma unroll
            for (int j = 0; j < 8; ++j) { tu32x2 w; w.x = cvt2bf(x[j][0], x[j][1]); w.y = cvt2bf(x[j][2], x[j][3]); __builtin_nontemporal_store(w, (tu32x2*)xq + 64 * j); } }
        if (dstk == 2) { float* xd = C.out + (size_t)row * D;
#pragma unroll
            for (int j = 0; j < 8; ++j) __builtin_nontemporal_store(x[j], (f32x4*)xd + lane + 64 * j); }
        if (has_pre) {
            float ss = 0.f;
#pragma unroll
            for (int j = 0; j < 8; ++j) ss += (x[j][0] * x[j][0] + x[j][1] * x[j][1]) + (x[j][2] * x[j][2] + x[j][3] * x[j][3]);
            const float rstd = rsqrtf(wave_sum(ss) * (1.0f / D) + EPSN);
            uint2* hp = (uint2*)(HB + (size_t)row * D) + lane;
#pragma unroll
            for (int j = 0; j < 8; ++j) { const f32x4 h = (x[j] * rstd) * vB[64 * j] + vC[64 * j]; uint2 w; w.x = cvt2bf(h[0], h[1]); w.y = cvt2bf(h[2], h[3]); hp[64 * j] = w; }
        }
    }
    __syncthreads();
}

typedef float f32x16 __attribute__((ext_vector_type(16)));
typedef unsigned u32x4 __attribute__((ext_vector_type(4)));
typedef short s16x4 __attribute__((ext_vector_type(4)));
typedef short v4i16_t __attribute__((ext_vector_type(4)));
typedef float f32x2_t __attribute__((ext_vector_type(2))); typedef __bf16 bf16x2_t __attribute__((ext_vector_type(2)));
__device__ __forceinline__ unsigned cvtpk_s(float lo, float hi) { f32x2_t v = {lo, hi}; bf16x2_t b = __builtin_convertvector(v, bf16x2_t); return __builtin_bit_cast(unsigned, b); }
__device__ __forceinline__ unsigned off_a(unsigned row, unsigned ch) { return 2048u * (row >> 3) + 512u * (ch >> 2) + 64u * (row & 7) + 16u * ((ch & 3) ^ ((row >> 2) & 3)); }
__device__ __forceinline__ s16x4 vtr(LAS const unsigned char* p) { return __builtin_bit_cast(s16x4, __builtin_amdgcn_ds_read_tr16_b64_v4i16((LAS v4i16_t*)p)); }

template <int OFF> __device__ __forceinline__ void vrd8(unsigned alo, unsigned ahi, s16x4 (&v)[8]) {
    asm volatile("ds_read_b64_tr_b16 %0, %8 offset:%10\n\tds_read_b64_tr_b16 %1, %9 offset:%10\n\t"
                 "ds_read_b64_tr_b16 %2, %8 offset:%11\n\tds_read_b64_tr_b16 %3, %9 offset:%11\n\t"
                 "ds_read_b64_tr_b16 %4, %8 offset:%12\n\tds_read_b64_tr_b16 %5, %9 offset:%12\n\t"
                 "ds_read_b64_tr_b16 %6, %8 offset:%13\n\tds_read_b64_tr_b16 %7, %9 offset:%13"
                 : "=&v"(v[0]), "=&v"(v[1]), "=&v"(v[2]), "=&v"(v[3]), "=&v"(v[4]), "=&v"(v[5]), "=&v"(v[6]), "=&v"(v[7])
                 : "v"(alo), "v"(ahi), "n"(OFF), "n"(OFF + 512), "n"(OFF + 1024), "n"(OFF + 1536) : "memory");
}
template <int N> __device__ __forceinline__ void vwait8(s16x4 (&v)[8]) {
    asm volatile("s_waitcnt lgkmcnt(%8)" : "+v"(v[0]), "+v"(v[1]), "+v"(v[2]), "+v"(v[3]), "+v"(v[4]), "+v"(v[5]), "+v"(v[6]), "+v"(v[7]) : "n"(N) : "memory");
}
template <int OFF> __device__ __forceinline__ void krd4(unsigned ke, unsigned ko, u32x4 (&a)[4]) {
    asm volatile("ds_read_b128 %0, %4 offset:%6\n\tds_read_b128 %1, %4 offset:%7\n\tds_read_b128 %2, %5 offset:%6\n\tds_read_b128 %3, %5 offset:%7"
                 : "=&v"(a[0]), "=&v"(a[1]), "=&v"(a[2]), "=&v"(a[3]) : "v"(ke), "v"(ko), "n"(OFF), "n"(OFF + 8192) : "memory");
}
template <int N> __device__ __forceinline__ void kwait4(u32x4 (&a)[4]) {
    asm volatile("s_waitcnt lgkmcnt(%4)" : "+v"(a[0]), "+v"(a[1]), "+v"(a[2]), "+v"(a[3]) : "n"(N) : "memory");
}

__device__ __forceinline__ void attn_mfma(const Ctx& C, const bf16* Q, const bf16* Kb, const bf16* Vb, const float* sink, bf16* O, bool with_ctx) {
    const int lane = C.lane, w = C.wave, r = lane & 31, h = lane >> 5, tid = C.tid;
    LAS unsigned char* lds = C.lds;
    const int vcu = (C.G % 8 == 0) ? ((int)blockIdx.x % 8) * (C.G / 8) + (int)blockIdx.x / 8 : (int)blockIdx.x;
    const int NU = 2048 + (with_ctx ? 32 : 0);
    const int drow = 8 * w + ((lane >> 2) & 7), dch0 = 4 * (lane >> 5) + ((lane & 3) ^ ((drow >> 2) & 3));
    const unsigned blk = (lane >> 4) & 1, tq = (lane & 15) >> 2, tp = lane & 3;
    const unsigned ke0 = (unsigned)(size_t)lds + 2048u * (r >> 3) + 64u * (r & 7) + 16u * ((unsigned)h ^ ((r >> 2) & 3));
    const unsigned ko0 = (unsigned)(size_t)lds + 2048u * (r >> 3) + 64u * (r & 7) + 16u * ((unsigned)(2 + h) ^ ((r >> 2) & 3));
    const unsigned vlo0 = (unsigned)(size_t)lds + 64u * (4 * h + tq) + 16u * ((2 * blk + (tp >> 1)) ^ (unsigned)h) + 8u * (tp & 1);
    const unsigned vhi0 = (unsigned)(size_t)lds + 2048u + 64u * (4 * h + tq) + 16u * ((2 * blk + (tp >> 1)) ^ (unsigned)(h + 2)) + 8u * (tp & 1);
    const int sinkv = __builtin_bit_cast(int, sink[lane & 15] * 1.4426950408889634f);
    const int qs = (w < 4) ? (w & 3) : 3 - (w & 3);
    const bool late = w >= 4;
    int ksl = 0, vsl = 0;
    for (int u = vcu; u < NU; u += C.G) {
        int b, n, hk, gp; const bool isctx = u >= 2048;
        if (!isctx) { gp = u & 1; hk = (u >> 1) & 3; n = (u >> 3) & 127; b = u >> 10; }
        else { const int v = u - 2048; gp = v & 1; hk = (v >> 1) & 3; n = (v >> 3) & 1; b = v >> 4; }
        const int hd = hk * 4 + gp * 2 + (w >> 2);
        const int qrow0 = isctx ? MLAT + b * CTXL + n * 128 : b * SEQ + n * 128;
        const int qi = 32 * qs + r;
        bf16x8 qf[8];
        f32x16 Oacc[4];
#pragma unroll
        for (int dt = 0; dt < 4; ++dt)
#pragma unroll
            for (int i = 0; i < 16; ++i) Oacc[dt][i] = 0.f;
        float m = __builtin_bit_cast(float, __builtin_amdgcn_readlane(sinkv, __builtin_amdgcn_readfirstlane(hd))), l = h == 0 ? 1.0f : 0.0f;
        int ti = isctx ? 6 : (n == 0 ? 2 : 0);
#define ATT_TILE_ROW(t_) ((t_) < 6 ? (size_t)b * SEQ + (size_t)(n - 1 + ((t_) >> 1)) * 128 + ((t_) & 1) * 64 : (size_t)MLAT + b * CTXL + ((t_) - 6) * 64)
#define ATT_DMA(src_, t_, dstoff_) do { const unsigned char* g_ = (const unsigned char*)((src_) + (ATT_TILE_ROW(t_) + drow) * KVD + hk * 128) + dch0 * 16; \
            __builtin_amdgcn_global_load_lds((const unsigned*)g_, (LAS unsigned*)(lds + (dstoff_) + 2048 * w), 16, 0, 0); \
            __builtin_amdgcn_global_load_lds((const unsigned*)(g_ + 128), (LAS unsigned*)(lds + (dstoff_) + 2048 * w + 1024), 16, 0, 0); } while (0)
#define ATT_DMAKV(t_, ks_, vs_) do { ATT_DMA(Kb, t_, (ks_) * 16384); ATT_DMA(Vb, t_, 49152 + (vs_) * 16384); } while (0)
#define ATT_NEXT(t_) (((t_) + 1 == 4 && !isctx && n == 127) ? 6 : (t_) + 1)
        ATT_DMAKV(ti, ksl, vsl);
        { const u32x4* qp = (const u32x4*)(Q + (size_t)(qrow0 + qi) * D + hd * 128);
#pragma unroll
          for (int s = 0; s < 8; ++s) qf[s] = __builtin_bit_cast(bf16x8, __builtin_nontemporal_load(qp + 2 * s + h)); }
        asm volatile("" : "+v"(qf[0]), "+v"(qf[1]), "+v"(qf[2]), "+v"(qf[3]), "+v"(qf[4]), "+v"(qf[5]), "+v"(qf[6]), "+v"(qf[7]));
        ATT_DMAKV(ATT_NEXT(ti), (ksl == 2 ? 0 : ksl + 1), ((vsl + 1) & 3));
        asm volatile("s_waitcnt vmcnt(4)" ::: "memory");
        asm volatile("s_waitcnt lgkmcnt(0)\n\ts_barrier" ::: "memory");
        bool pend = false; unsigned palo = 0, pahi = 0; u32x4 pw[4];
#define ATT_PVG(g_) do { vwait8<((g_) < 3 ? 8 : 0)>(vv[(g_) & 1]); const bf16x8 pb = __builtin_bit_cast(bf16x8, pw[g_]); \
                    _Pragma("unroll") for (int dt = 0; dt < 4; ++dt) { \
                        const s16x4 lo = vv[(g_) & 1][2 * dt], hi = vv[(g_) & 1][2 * dt + 1]; \
                        const bf16x8 va = (bf16x8){lo[0], lo[1], lo[2], lo[3], hi[0], hi[1], hi[2], hi[3]}; \
                        Oacc[dt] = __builtin_amdgcn_mfma_f32_32x32x16_bf16(va, pb, Oacc[dt], 0, 0, 0); } \
                    if ((g_) < 2) vrd8<49152 + 4096 * ((g_) + 2 < 3 ? (g_) + 2 : 3)>(palo, pahi, vv[(g_) & 1]);        \
                    __builtin_amdgcn_sched_barrier(0); } while (0)
#define ATT_PVALL() do { s16x4 vv[2][8]; vrd8<49152>(palo, pahi, vv[0]); vrd8<49152 + 4096>(palo, pahi, vv[1]); ATT_PVG(0); ATT_PVG(1); ATT_PVG(2); ATT_PVG(3); } while (0)
        for (;;) {
            const int tn = ATT_NEXT(ti); const bool more = tn < 10;
            const int tnn = ATT_NEXT(tn); const bool more2 = more && tnn < 10;
            const int kn = ksl == 2 ? 0 : ksl + 1, kw = kn == 2 ? 0 : kn + 1, vn = (vsl + 1) & 3, vw = (vsl + 2) & 3;
            if (more2) ATT_DMAKV(tnn, kw, vw);
            if (pend) { ATT_PVALL(); pend = false; }
            const int mtp = (ti < 6) ? (ti >> 1) : 1;
            const int kbase = (ti & 1) * 64;
            const bool skip = (mtp == 0 && kbase + 63 < 32 * qs) || (mtp == 2 && kbase > 32 * qs + 31);
            const bool needmask = (mtp == 0 && kbase < 32 * qs + 31) || (mtp == 2 && kbase + 63 > 32 * qs);
            if (!skip) {
                f32x16 S0, S1;
#pragma unroll
                for (int i = 0; i < 16; ++i) { S0[i] = 0.f; S1[i] = 0.f; }
                { u32x4 ka[4][4];
                  const unsigned ke = ke0 + ksl * 16384, ko = ko0 + ksl * 16384;
                  krd4<0>(ke, ko, ka[0]); krd4<512>(ke, ko, ka[1]); krd4<1024>(ke, ko, ka[2]); krd4<1536>(ke, ko, ka[3]);
#define ATT_QK(j_, n_) do { kwait4<n_>(ka[j_]); \
                      S0 = __builtin_amdgcn_mfma_f32_32x32x16_bf16(__builtin_bit_cast(bf16x8, ka[j_][0]), qf[2 * (j_)], S0, 0, 0, 0); \
                      S1 = __builtin_amdgcn_mfma_f32_32x32x16_bf16(__builtin_bit_cast(bf16x8, ka[j_][1]), qf[2 * (j_)], S1, 0, 0, 0); \
                      S0 = __builtin_amdgcn_mfma_f32_32x32x16_bf16(__builtin_bit_cast(bf16x8, ka[j_][2]), qf[2 * (j_) + 1], S0, 0, 0, 0); \
                      S1 = __builtin_amdgcn_mfma_f32_32x32x16_bf16(__builtin_bit_cast(bf16x8, ka[j_][3]), qf[2 * (j_) + 1], S1, 0, 0, 0); \
                      __builtin_amdgcn_sched_barrier(0); } while (0)
                  ATT_QK(0, 12); ATT_QK(1, 8); ATT_QK(2, 4); ATT_QK(3, 0);
#undef ATT_QK
                }
                if (needmask) {
                    const int thr = qi - kbase - 4 * h;
                    if (mtp == 0) {
#pragma unroll
                        for (int i = 0; i < 16; ++i) { const int c = (i & 3) + 8 * (i >> 2); if (c < thr) S0[i] = -__builtin_inff(); if (c + 32 < thr) S1[i] = -__builtin_inff(); }
                    } else {
#pragma unroll
                        for (int i = 0; i < 16; ++i) { const int c = (i & 3) + 8 * (i >> 2); if (c > thr) S0[i] = -__builtin_inff(); if (c + 32 > thr) S1[i] = -__builtin_inff(); }
                    }
                }
                float mx = fmaxf(S0[0], S1[0]);
#pragma unroll
                for (int i = 1; i < 16; ++i) mx = fmaxf(mx, fmaxf(S0[i], S1[i]));
                mx = fmaxf(mx, __shfl_xor(mx, 32));
                if (__any(mx > m + 8.0f)) {
                    const float mn = fmaxf(m, mx), alpha = __builtin_amdgcn_exp2f(m - mn); m = mn; l *= alpha;
#pragma unroll
                    for (int dt = 0; dt < 4; ++dt)
#pragma unroll
                        for (int i = 0; i < 16; ++i) Oacc[dt][i] *= alpha;
                }
                float rs = 0.f;
#pragma unroll
                for (int i = 0; i < 16; ++i) { S0[i] = __builtin_amdgcn_exp2f(S0[i] - m); S1[i] = __builtin_amdgcn_exp2f(S1[i] - m); rs += S0[i] + S1[i]; }
                l += rs;
#pragma unroll
                for (int s2 = 0; s2 < 2; ++s2) {
                    pw[s2].x = cvtpk_s(S0[8 * s2 + 0], S0[8 * s2 + 1]); pw[s2].y = cvtpk_s(S0[8 * s2 + 2], S0[8 * s2 + 3]); pw[s2].z = cvtpk_s(S0[8 * s2 + 4], S0[8 * s2 + 5]); pw[s2].w = cvtpk_s(S0[8 * s2 + 6], S0[8 * s2 + 7]);
                    pw[2 + s2].x = cvtpk_s(S1[8 * s2 + 0], S1[8 * s2 + 1]); pw[2 + s2].y = cvtpk_s(S1[8 * s2 + 2], S1[8 * s2 + 3]); pw[2 + s2].z = cvtpk_s(S1[8 * s2 + 4], S1[8 * s2 + 5]); pw[2 + s2].w = cvtpk_s(S1[8 * s2 + 6], S1[8 * s2 + 7]); }
                palo = vlo0 + vsl * 16384; pahi = vhi0 + vsl * 16384;
                if (late) pend = true; else ATT_PVALL();
            }
            if (more2) { asm volatile("s_waitcnt vmcnt(4)" ::: "memory"); } else { asm volatile("s_waitcnt vmcnt(0)" ::: "memory"); }
            asm volatile("s_waitcnt lgkmcnt(0)\n\ts_barrier" ::: "memory");
            if (!more) { ksl = kn; vsl = vn; break; }
            ti = tn; ksl = kn; vsl = vn;
        }
        if (pend) ATT_PVALL();
#undef ATT_PVG
#undef ATT_PVALL
        const float lt = l + __shfl_xor(l, 32), inv = 1.0f / lt;
        bf16* orow = O + (size_t)(qrow0 + qi) * D + hd * 128 + (h ? 8 : 0);
#pragma unroll
        for (int dt = 0; dt < 4; ++dt)
#pragma unroll
            for (int gp2 = 0; gp2 < 2; ++gp2) {
                unsigned ax = cvtpk_s(Oacc[dt][8 * gp2 + 0] * inv, Oacc[dt][8 * gp2 + 1] * inv), ay = cvtpk_s(Oacc[dt][8 * gp2 + 2] * inv, Oacc[dt][8 * gp2 + 3] * inv);
                unsigned bx = cvtpk_s(Oacc[dt][8 * gp2 + 4] * inv, Oacc[dt][8 * gp2 + 5] * inv), by = cvtpk_s(Oacc[dt][8 * gp2 + 6] * inv, Oacc[dt][8 * gp2 + 7] * inv);
                const auto rx = __builtin_amdgcn_permlane32_swap(ax, bx, false, false); const auto ry = __builtin_amdgcn_permlane32_swap(ay, by, false, false);
                u32x4 wv; wv.x = rx[0]; wv.y = ry[0]; wv.z = rx[1]; wv.w = ry[1];
                *(u32x4*)(orow + 32 * dt + 16 * gp2) = wv; }
#undef ATT_TILE_ROW
#undef ATT_DMA
#undef ATT_DMAKV
#undef ATT_NEXT
    }
}

__device__ __forceinline__ float gelu_tanh(float x) { const float z2 = 1.5957691216057308f * (x + 0.044715f * x * x * x); return x * __builtin_amdgcn_rcpf(1.0f + __expf(-z2)); }

constexpr int TOKS = CTXL + SEQ;
constexpr int NCHK = 130;
constexpr int SS_KT = 131072, SS_KTD = 4608, SS_ST = SS_KT + 2 * SS_KTD;
constexpr int ST_F = 1152, ST_A16 = 1280, ST_A32 = 1408, ST_A64 = 1536, ST_A128 = 1664;
__device__ __forceinline__ unsigned swzb(unsigned row, unsigned chunk) { return row * 256u + ((chunk ^ (row & 15u)) << 4); }
template <int CTRL> __device__ __forceinline__ float dppf(float v) { return __int_as_float(__builtin_amdgcn_update_dpp(0, __float_as_int(v), CTRL, 0xf, 0xf, true)); }
template <int CTRL> __device__ __forceinline__ float dppfo(float o, float v) { return __int_as_float(__builtin_amdgcn_update_dpp(__float_as_int(o), __float_as_int(v), CTRL, 0xf, 0xf, false)); }
template <int CTRL> __device__ __forceinline__ f32x4 dpp4o(const f32x4 o, const f32x4 v) { return (f32x4){dppfo<CTRL>(o[0], v[0]), dppfo<CTRL>(o[1], v[1]), dppfo<CTRL>(o[2], v[2]), dppfo<CTRL>(o[3], v[3])}; }
template <int CTRL> __device__ __forceinline__ f32x4 dpp4(const f32x4 v) { return (f32x4){dppf<CTRL>(v[0]), dppf<CTRL>(v[1]), dppf<CTRL>(v[2]), dppf<CTRL>(v[3])}; }
__device__ __forceinline__ f32x4 cmul2(const f32x4 m, const f32x4 x) { return (f32x4){m[0] * x[0] - m[1] * x[1], m[0] * x[1] + m[1] * x[0], m[2] * x[2] - m[3] * x[3], m[2] * x[3] + m[3] * x[2]}; }
__device__ __forceinline__ f32x4 cfma2(const f32x4 m, const f32x4 x, const f32x4 s) {
    f32x2_t s0 = {s[0], s[1]}, s1 = {s[2], s[3]};
    const f32x2_t m0 = {m[0], m[1]}, m1 = {m[2], m[3]}, x0 = {x[0], x[1]}, x1 = {x[2], x[3]};
    asm("v_pk_fma_f32 %0, %1, %2, %0 op_sel_hi:[0,1,1]\n\tv_pk_fma_f32 %0, %1, %2, %0 op_sel:[1,1,0] op_sel_hi:[1,0,1] neg_lo:[1,0,0]" : "+v"(s0) : "v"(m0), "v"(x0));
    asm("v_pk_fma_f32 %0, %1, %2, %0 op_sel_hi:[0,1,1]\n\tv_pk_fma_f32 %0, %1, %2, %0 op_sel:[1,1,0] op_sel_hi:[1,0,1] neg_lo:[1,0,0]" : "+v"(s1) : "v"(m1), "v"(x1));
    return (f32x4){s0[0], s0[1], s1[0], s1[1]};
}
#define MFMA16(a, b, c) __builtin_amdgcn_mfma_f32_16x16x32_bf16((a), (b), (c), 0, 0, 0)

__device__ __forceinline__ void ssm_load_u(const int d, const int k, const bf16* Ugbg, const int lane_in, bf16x8 (&uf)[4]) {
    int lane = lane_in; asm volatile("" : "+v"(lane));
    const int n = lane & 15, q = lane >> 4;
    const int pb = k < 2 ? 0 : CTXL, pl = k < 2 ? CTXL : SEQ, kk = k < 2 ? k : k - 2;
#pragma unroll
    for (int ks = 0; ks < 4; ++ks) { const int idx = kk * 128 + n * 8 + 2 * ks + (q >> 1); const int tok = pb + (d ? pl - 1 - idx : idx);
        uf[ks] = *(const bf16x8*)(Ugbg + (size_t)tok * 16 + 8 * (q & 1)); }
}
template <int MODE> __device__ __forceinline__ void ssm_chunk(LAS const unsigned char* lds, const int d, const bf16x8 (&uf)[4], f32x4 (&hc)[8], const float* Hnext, float* Ek, f32x4 (&acc)[8], const int lane_in) {
    int lane = lane_in; asm volatile("" : "+v"(lane));
    const int n = lane & 15, q = lane >> 4;
    LAS const unsigned char* Pt = lds + d * 65536; LAS const unsigned char* Rt = Pt + 32768;
    LAS const unsigned char* Kt = lds + SS_KT + d * SS_KTD; LAS const float* ST = (LAS const float*)(lds + SS_ST + d * 7168);
    f32x4 S[8];
    { bf16x8 pa[2][8];
#pragma unroll
      for (int j = 0; j < 8; ++j) pa[0][j] = *(LAS const bf16x8*)(Pt + swzb(16 * (j >> 2) + n, 4 * (j & 3) + q));
#pragma unroll
      for (int mb = 0; mb < 4; ++mb) {
          if (mb < 3) {
#pragma unroll
              for (int j = 0; j < 8; ++j) pa[(mb + 1) & 1][j] = *(LAS const bf16x8*)(Pt + swzb(16 * (2 * mb + 2 + (j >> 2)) + n, 4 * (j & 3) + q)); }
#pragma unroll
          for (int j = 0; j < 8; ++j) { const int m = 2 * mb + (j >> 2); if ((j & 3) == 0) S[m] = (f32x4){0.f, 0.f, 0.f, 0.f}; S[m] = MFMA16(pa[mb & 1][j], uf[j & 3], S[m]); }
          __builtin_amdgcn_sched_barrier(0); } }
    if (MODE == 0) {
#pragma unroll
        for (int m = 0; m < 8; ++m) { f32x4 y = cmul2(hc[m], S[m]);
            { float x0 = y[0], x1 = y[1], x2 = y[2], x3 = y[3];
              asm("s_nop 1\n\tv_add_f32_dpp %0, %0, %0 row_shr:1 row_mask:0xf bank_mask:0xf bound_ctrl:1\n\tv_add_f32_dpp %1, %1, %1 row_shr:1 row_mask:0xf bank_mask:0xf bound_ctrl:1\n\tv_add_f32_dpp %2, %2, %2 row_shr:1 row_mask:0xf bank_mask:0xf bound_ctrl:1\n\tv_add_f32_dpp %3, %3, %3 row_shr:1 row_mask:0xf bank_mask:0xf bound_ctrl:1\n\tv_add_f32_dpp %0, %0, %0 row_shr:2 row_mask:0xf bank_mask:0xf bound_ctrl:1\n\tv_add_f32_dpp %1, %1, %1 row_shr:2 row_mask:0xf bank_mask:0xf bound_ctrl:1\n\tv_add_f32_dpp %2, %2, %2 row_shr:2 row_mask:0xf bank_mask:0xf bound_ctrl:1\n\tv_add_f32_dpp %3, %3, %3 row_shr:2 row_mask:0xf bank_mask:0xf bound_ctrl:1\n\tv_add_f32_dpp %0, %0, %0 row_shr:4 row_mask:0xf bank_mask:0xf bound_ctrl:1\n\tv_add_f32_dpp %1, %1, %1 row_shr:4 row_mask:0xf bank_mask:0xf bound_ctrl:1\n\tv_add_f32_dpp %2, %2, %2 row_shr:4 row_mask:0xf bank_mask:0xf bound_ctrl:1\n\tv_add_f32_dpp %3, %3, %3 row_shr:4 row_mask:0xf bank_mask:0xf bound_ctrl:1\n\tv_add_f32_dpp %0, %0, %0 row_shr:8 row_mask:0xf bank_mask:0xf bound_ctrl:1\n\tv_add_f32_dpp %1, %1, %1 row_shr:8 row_mask:0xf bank_mask:0xf bound_ctrl:1\n\tv_add_f32_dpp %2, %2, %2 row_shr:8 row_mask:0xf bank_mask:0xf bound_ctrl:1\n\tv_add_f32_dpp %3, %3, %3 row_shr:8 row_mask:0xf bank_mask:0xf bound_ctrl:1" : "+v"(x0), "+v"(x1), "+v"(x2), "+v"(x3));
              y = (f32x4){x0, x1, x2, x3}; }
            S[m] = y; }
        if (n == 15) {
#pragma unroll
            for (int m = 0; m < 8; ++m) *(f32x4*)(Ek + (8 * m + 2 * q) * 2) = S[m]; }
        return;
    }
    f32x4 mmv[8];
#pragma unroll
    for (int m = 0; m < 8; ++m) mmv[m] = *(LAS const f32x4*)(ST + 8 * 128 + (8 * m + 2 * q) * 2);
    if (MODE == 1) {
        { const float z = n == 0 ? 1.0f : 0.0f;
#pragma unroll
          for (int m = 0; m < 8; ++m) S[m] = cfma2(mmv[m], hc[m] * z, S[m]); }
        __builtin_amdgcn_sched_barrier(0);
    }
#pragma unroll
    for (int m = 0; m < 8; ++m) S[m] = cfma2(mmv[m], dpp4<0x111>(S[m]), S[m]);
    __builtin_amdgcn_sched_barrier(0);
#pragma unroll
    for (int m = 0; m < 8; ++m) mmv[m] = *(LAS const f32x4*)(ST + ST_A16 + (8 * m + 2 * q) * 2);
#pragma unroll
    for (int m = 0; m < 8; ++m) S[m] = cfma2(mmv[m], dpp4<0x112>(S[m]), S[m]);
    __builtin_amdgcn_sched_barrier(0);
#pragma unroll
    for (int m = 0; m < 8; ++m) mmv[m] = *(LAS const f32x4*)(ST + ST_A32 + (8 * m + 2 * q) * 2);
#pragma unroll
    for (int m = 0; m < 8; ++m) S[m] = cfma2(mmv[m], dpp4<0x114>(S[m]), S[m]);
    __builtin_amdgcn_sched_barrier(0);
#pragma unroll
    for (int m = 0; m < 8; ++m) mmv[m] = *(LAS const f32x4*)(ST + ST_A64 + (8 * m + 2 * q) * 2);
#pragma unroll
    for (int m = 0; m < 8; ++m) S[m] = cfma2(mmv[m], dpp4<0x118>(S[m]), S[m]);
    __builtin_amdgcn_sched_barrier(0);
    if (MODE == 0) {
        if (n == 15) {
#pragma unroll
            for (int m = 0; m < 8; ++m) *(f32x4*)(Ek + (8 * m + 2 * q) * 2) = S[m]; }
        return;
    }
    bf16x8 hb[4];
#pragma unroll
    for (int ks2 = 0; ks2 < 4; ++ks2) {
        const f32x4 h0 = dpp4o<0x111>(hc[2 * ks2], S[2 * ks2]), h1 = dpp4o<0x111>(hc[2 * ks2 + 1], S[2 * ks2 + 1]);
        u32x4 w; w.x = cvtpk_s(h0[0], h0[1]); w.y = cvtpk_s(h0[2], h0[3]); w.z = cvtpk_s(h1[0], h1[1]); w.w = cvtpk_s(h1[2], h1[3]);
        hb[ks2] = __builtin_bit_cast(bf16x8, w);
    }
    __builtin_amdgcn_sched_barrier(0);
#pragma unroll
    for (int m = 0; m < 8; ++m) hc[m] = *(const f32x4*)(Hnext + (8 * m + 2 * q) * 2);
    __builtin_amdgcn_sched_barrier(0);
    u32x4 ra[2][4], kq[2][4];
#define SSM_LOADT(t_, b_) do { _Pragma("unroll") for (int ks2 = 0; ks2 < 4; ++ks2) ra[b_][ks2] = *(LAS const u32x4*)(Rt + swzb(16 * (t_) + n, 4 * ks2 + q)); \
        _Pragma("unroll") for (int ks = 0; ks <= (t_) / 2; ++ks) kq[b_][ks] = *(LAS const u32x4*)(Kt + ((t_) - 2 * ks - (q >> 1) + 1) * 512 + n * 32 + (q & 1) * 16); } while (0)
    SSM_LOADT(0, 0);
#pragma unroll
    for (int t = 0; t < 8; ++t) {
        if (t < 7) SSM_LOADT(t + 1, (t + 1) & 1);
#pragma unroll
        for (int ks2 = 0; ks2 < 4; ++ks2) acc[t] = MFMA16(__builtin_bit_cast(bf16x8, ra[t & 1][ks2]), hb[ks2], acc[t]);
#pragma unroll
        for (int ks = 0; ks <= t / 2; ++ks) acc[t] = MFMA16(__builtin_bit_cast(bf16x8, kq[t & 1][ks]), uf[ks], acc[t]);
        __builtin_amdgcn_sched_barrier(0);
    }
#undef SSM_LOADT
}

__device__ __forceinline__ void ssm_phase(const Ctx& C, const bf16* Ug, float* EH, bf16* Gout) {
    const int tid_in = C.tid, tid = C.tid, lane = C.lane, w = C.wave;
    LAS unsigned char* lds = C.lds;
    const float* a_re = C.in[13]; const float* a_im = C.in[14]; const float* log_dt = C.in[15];
    const float* b_re = C.in[16]; const float* b_im = C.in[17]; const float* c_re = C.in[18]; const float* c_im = C.in[19]; const float* dskip = C.in[20];
    for (int unit = (int)blockIdx.x; unit < 256; unit += C.G) {
        const int xx = unit & 7, yy = unit >> 3, zz = xx * 8 + (yy >> 2), b = zz >> 5, g = (zz & 31) * 4 + (yy & 3);
        LAS unsigned char* stg = lds + 65536 + 32768;
        { f32x4 tmp[4]; int tid = tid_in; asm volatile("" : "+v"(tid));
#pragma unroll
          for (int i = 0; i < 4; ++i) { const int idx = tid + 512 * i, a_ = idx >> 8, off = idx & 255, dg_ = (a_ >> 2) * 128 + g, k_ = a_ & 3;
              const float* src = (k_ == 0 ? b_re : k_ == 1 ? b_im : k_ == 2 ? c_re : c_im) + (size_t)dg_ * 1024;
              tmp[i] = *(const f32x4*)(src + off * 4); }
#pragma unroll
          for (int i = 0; i < 4; ++i) { const int idx = tid + 512 * i; *(LAS f32x4*)(stg + (idx >> 8) * 4096 + (idx & 255) * 16) = tmp[i]; } }
        if (tid < 128) { const int d = tid >> 6, p = tid & 63, dg = d * 128 + g;
            LAS float* ST = (LAS float*)(lds + SS_ST + d * 7168);
            const double are = (double)a_re[dg * 64 + p], aim = (double)a_im[dg * 64 + p], dt = (double)expf(log_dt[dg]);
            const double mg = exp(are * dt); double sn, cs; sincos(aim * dt, &sn, &cs); const double ar1 = mg * cs, ai1 = mg * sn;
            { const double xr = ar1 - 1.0, xi = ai1, den = are * are + aim * aim;
              ST[ST_F + p * 2] = (float)((xr * are + xi * aim) / den); ST[ST_F + p * 2 + 1] = (float)((xi * are - xr * aim) / den); }
            double pr = 1.0, pi = 0.0;
#pragma unroll 1
            for (int j = 0; j <= 8; ++j) { ST[(j * 64 + p) * 2] = (float)pr; ST[(j * 64 + p) * 2 + 1] = (float)pi; const double nr = pr * ar1 - pi * ai1, ni = pr * ai1 + pi * ar1; pr = nr; pi = ni; }
            double qr = ar1, qi = ai1;
#pragma unroll 1
            for (int sq = 0; sq < 3; ++sq) { const double nr = qr * qr - qi * qi, ni = 2.0 * qr * qi; qr = nr; qi = ni; }
#pragma unroll 1
            for (int jj = 0; jj < 4; ++jj) { const double nr = qr * qr - qi * qi, ni = 2.0 * qr * qi; qr = nr; qi = ni;
                ST[ST_A16 + jj * 128 + p * 2] = (float)qr; ST[ST_A16 + jj * 128 + p * 2 + 1] = (float)qi; }
        }
        __syncthreads();
#pragma unroll 1
        for (int d = 0; d < 2; ++d) {
            int tid = tid_in; asm volatile("" : "+v"(tid));
            LAS const float* ST = (LAS const float*)(lds + SS_ST + d * 7168);
            LAS const float* Sbr = (LAS const float*)(stg + d * 16384); LAS const float* Sbi = Sbr + 1024; LAS const float* Scr = Sbr + 2048; LAS const float* Sci = Sbr + 3072;
            LAS unsigned char* Pt = lds + d * 65536; LAS unsigned char* Kt = lds + SS_KT + d * SS_KTD;
            {
              const int col = tid & 127, row0 = tid >> 7, s_ = col >> 4, cp = col & 15, comp = row0 & 1;
#pragma unroll 8
              for (int i = 0; i < 32; ++i) { const int row = row0 + 4 * i, p = row >> 1;
                  const float br = Sbr[p * 16 + cp], bi = Sbi[p * 16 + cp];
                  const float fr = ST[ST_F + p * 2], fi = ST[ST_F + p * 2 + 1], bbr = fr * br - fi * bi, bbi = fr * bi + fi * br;
                  const float ar = ST[((7 - s_) * 64 + p) * 2], ai = ST[((7 - s_) * 64 + p) * 2 + 1];
                  const float v = comp ? ar * bbi + ai * bbr : ar * bbr - ai * bbi;
                  *(LAS bf16*)(Pt + swzb(row, col >> 3) + (col & 7) * 2) = (bf16)f2bf(v); } }
            {
              const int c = (tid >> 4) & 15, cp = tid & 15, lag0 = tid >> 8; float sum[4] = {0.f, 0.f, 0.f, 0.f};
#pragma unroll 8
              for (int p = 0; p < 64; ++p) {
                  const float br = Sbr[p * 16 + cp], bi = Sbi[p * 16 + cp];
                  const float cr = Scr[c * 64 + p], ci = Sci[c * 64 + p];
                  const float fr = ST[ST_F + p * 2], fi = ST[ST_F + p * 2 + 1], bbr = fr * br - fi * bi, bbi = fr * bi + fi * br;
                  const float wr = cr * bbr - ci * bbi, wi = cr * bbi + ci * bbr;
#pragma unroll
                  for (int i = 0; i < 4; ++i) { const int lag = lag0 + 2 * i; const float ar = ST[(lag * 64 + p) * 2], ai = ST[(lag * 64 + p) * 2 + 1]; sum[i] += wr * ar - wi * ai; } }
#pragma unroll
              for (int i = 0; i < 4; ++i) *(LAS bf16*)(Kt + (1 + lag0 + 2 * i) * 512 + c * 32 + cp * 2) = (bf16)f2bf(sum[i]);
              if (tid < 128) ((LAS unsigned*)Kt)[tid] = 0u; }
        }
#pragma unroll 1
        for (int d = 0; d < 2; ++d) {
            int tid = tid_in; asm volatile("" : "+v"(tid));
            LAS const float* ST = (LAS const float*)(lds + SS_ST + d * 7168);
            LAS const float* Scr = (LAS const float*)(stg + d * 16384) + 2048; LAS const float* Sci = Scr + 1024;
            LAS unsigned char* Rt = lds + d * 65536 + 32768;
            {
              const int col = tid & 127, ks2 = col >> 5, kpos = col & 31;
              const int pp = 32 * ks2 + 16 * ((kpos >> 2) & 1) + 4 * (kpos >> 3) + (kpos & 3), p = pp >> 1, comp = pp & 1;
              float cr[4], ci[4];
#pragma unroll
              for (int j = 0; j < 4; ++j) { const int c = (tid >> 7) + 4 * j; cr[j] = Scr[c * 64 + p]; ci[j] = Sci[c * 64 + p]; }
              asm volatile("" : "+v"(cr[0]), "+v"(cr[1]), "+v"(cr[2]), "+v"(cr[3]), "+v"(ci[0]), "+v"(ci[1]), "+v"(ci[2]), "+v"(ci[3]));
              __syncthreads();
#pragma unroll
              for (int t = 0; t < 8; ++t) { const float ar = ST[((t + 1) * 64 + p) * 2], ai = ST[((t + 1) * 64 + p) * 2 + 1];
#pragma unroll
                  for (int j = 0; j < 4; ++j) { const int row = t * 16 + (tid >> 7) + 4 * j;
                      const float v = comp ? -(cr[j] * ai + ci[j] * ar) : cr[j] * ar - ci[j] * ai;
                      *(LAS bf16*)(Rt + swzb(row, col >> 3) + (col & 7) * 2) = (bf16)f2bf(v); } } }
        }
        __syncthreads();
        const bf16* Ugbg = Ug + (size_t)(b * 128 + g) * TOKS * 16;
        float* Eb = EH + (size_t)unit * (4 * NCHK * 128); float* Hb = Eb + 2 * NCHK * 128;
        { f32x4 dummy[8]; bf16x8 ufa[4], ufb[4];
#pragma unroll 1
          for (int d = 0; d < 2; ++d) {
              f32x4 Wv[8];
              { int ln = lane; asm volatile("" : "+v"(ln)); const int e = 15 - (ln & 15), q = ln >> 4; LAS const float* ST = (LAS const float*)(lds + SS_ST + d * 7168);
#pragma unroll
                for (int m = 0; m < 8; ++m) { f32x4 wv = (f32x4){1.f, 0.f, 1.f, 0.f};
                    const f32x4 p8 = *(LAS const f32x4*)(ST + 8 * 128 + (8 * m + 2 * q) * 2), p16 = *(LAS const f32x4*)(ST + ST_A16 + (8 * m + 2 * q) * 2);
                    const f32x4 p32 = *(LAS const f32x4*)(ST + ST_A32 + (8 * m + 2 * q) * 2), p64 = *(LAS const f32x4*)(ST + ST_A64 + (8 * m + 2 * q) * 2);
                    if (e & 1) wv = cmul2(p8, wv); if (e & 2) wv = cmul2(p16, wv); if (e & 4) wv = cmul2(p32, wv); if (e & 8) wv = cmul2(p64, wv);
                    Wv[m] = wv; } }
              ssm_load_u(d, w, Ugbg, lane, ufa);
#pragma unroll 1
              for (int k = w; k < NCHK; k += 2 * NWAVES) {
                  const int k1 = k + NWAVES, k2 = k + 2 * NWAVES;
                  ssm_load_u(d, k1 < NCHK ? k1 : k, Ugbg, lane, ufb);
                  ssm_chunk<0>(lds, d, ufa, Wv, nullptr, Eb + (size_t)(d * NCHK + k) * 128, dummy, lane);
                  ssm_load_u(d, k2 < NCHK ? k2 : k, Ugbg, lane, ufa);
                  if (k1 < NCHK) ssm_chunk<0>(lds, d, ufb, Wv, nullptr, Eb + (size_t)(d * NCHK + k1) * 128, dummy, lane);
              } } }
        __syncthreads();
        if (tid < 128) { const int d = tid >> 6, p = tid & 63; LAS const float* ST = (LAS const float*)(lds + SS_ST + d * 7168);
            const float ar = ST[ST_A128 + p * 2], ai = ST[ST_A128 + p * 2 + 1]; float hr = 0.f, hi = 0.f;
            const float2* Ep = (const float2*)(Eb + (size_t)d * NCHK * 128) + p; float2* Hp = (float2*)(Hb + (size_t)d * NCHK * 128) + p;
#pragma unroll 1
            for (int k0 = 0; k0 < NCHK; k0 += 26) { float2 e[26];
#pragma unroll
                for (int j = 0; j < 26; ++j) e[j] = Ep[(size_t)(k0 + j) * 64];
#pragma unroll
                for (int j = 0; j < 26; ++j) { Hp[(size_t)(k0 + j) * 64] = make_float2(hr, hi); const float nr = ar * hr - ai * hi + e[j].x, ni = ar * hi + ai * hr + e[j].y; hr = nr; hi = ni; } }
        }
        __syncthreads();
        { bf16x8 ufa[4], ufb[4]; f32x4 hcs[8];
          ssm_load_u(0, 2 + w, Ugbg, lane, ufa);
          { int l0 = lane; asm volatile("" : "+v"(l0)); const int q0 = l0 >> 4;
#pragma unroll
            for (int m = 0; m < 8; ++m) hcs[m] = *(const f32x4*)(Hb + (size_t)(2 + w) * 128 + (8 * m + 2 * q0) * 2); }
#pragma unroll 1
          for (int kk = w; kk < 128; kk += NWAVES) {
              int ln = lane; asm volatile("" : "+v"(ln));
              const int n = ln & 15, q = ln >> 4;
              const f32x4 dsk = *(const f32x4*)(dskip + g * 16 + 4 * q);
              f32x4 accf[8], accb[8];
#pragma unroll
              for (int t = 0; t < 8; ++t) { accf[t] = (f32x4){0.f, 0.f, 0.f, 0.f}; accb[t] = (f32x4){0.f, 0.f, 0.f, 0.f}; }
              ssm_load_u(1, 2 + 127 - kk, Ugbg, lane, ufb);
              ssm_chunk<1>(lds, 0, ufa, hcs, Hb + (size_t)(NCHK + 2 + 127 - kk) * 128, nullptr, accf, lane);
              { const int kn = kk + NWAVES < 128 ? kk + NWAVES : kk; ssm_load_u(0, 2 + kn, Ugbg, lane, ufa); }
              uint2 uwv[8];
#pragma unroll
              for (int t = 0; t < 8; ++t) uwv[t] = *(const uint2*)(Ugbg + (size_t)(CTXL + kk * 128 + n * 8 + t) * 16 + 4 * q);
              ssm_chunk<1>(lds, 1, ufb, hcs, Hb + (size_t)(2 + (kk + NWAVES < 128 ? kk + NWAVES : kk)) * 128, nullptr, accb, lane);
#pragma unroll
              for (int tp2 = 0; tp2 < 4; ++tp2) {
                  unsigned gx[2], gy[2];
#pragma unroll
                  for (int tt = 0; tt < 2; ++tt) { const int t = 2 * tp2 + tt;
                      const f32x4 yb = dpp4<0x140>(accb[7 - t]);
                      const uint2 uw = uwv[t];
                      const f32x4 u = (f32x4){bflo(uw.x), bfhi(uw.x), bflo(uw.y), bfhi(uw.y)};
                      const f32x4 y = accf[t] + yb + dsk * u;
                      gx[tt] = cvtpk_s(gelu_tanh(y[0]), gelu_tanh(y[1])); gy[tt] = cvtpk_s(gelu_tanh(y[2]), gelu_tanh(y[3])); }
                  const auto sx = __builtin_amdgcn_permlane16_swap(gx[0], gx[1], false, false); const auto sy = __builtin_amdgcn_permlane16_swap(gy[0], gy[1], false, false);
                  u32x4 gw; gw.x = sx[0]; gw.y = sy[0]; gw.z = sx[1]; gw.w = sy[1];
                  const int tls = kk * 128 + n * 8 + 2 * tp2 + (q & 1);
                  *(u32x4*)(Gout + ((size_t)b * SEQ + tls) * D + g * 16 + 4 * (q & ~1)) = gw; }
          } }
        __syncthreads();
    }
}

constexpr int NPHASE = 22;
#ifndef MK_ONE_LAUNCH
#define MK_ONE_LAUNCH 1
#endif
__global__ void __launch_bounds__(NWAVES * 64, 2) fwd_kernel(Args args) {
    extern __shared__ __attribute__((aligned(16))) unsigned char lds_raw[];
    Ctx C;
    C.lds = (LAS unsigned char*)lds_raw;
    C.tid = threadIdx.x; C.lane = C.tid & 63; C.wave = __builtin_amdgcn_readfirstlane(C.tid >> 6);
    C.G = gridDim.x; C.gw = (int)blockIdx.x * NWAVES + C.wave; C.NGW = C.G * NWAVES;
    C.in = args.in; C.out = args.out; C.ws = args.ws;
    volatile LAS unsigned* MISC = (volatile LAS unsigned*)(C.lds + MISC_OFF);
    if (C.tid < 64) ((LAS unsigned*)(C.lds + MISC_OFF))[C.tid] = 0u;
    __syncthreads();
    XcdBarrier bar; bar.bar = (unsigned*)(C.ws + WS_CTL) + CW_BAR; bar.x = 0; bar.st = nullptr;
    if (MK_ONE_LAUNCH) bar = xcd_barrier_post((unsigned*)(C.ws + WS_CTL) + CW_BAR, MISC + 8);
    const int lo = args.ph_lo, hi = args.ph_hi;
#define IN(k) (lo <= (k) && (k) < hi)
#define SEAM(k) do { if (IN(k) && IN((k) + 1)) xcd_barrier(bar); } while (0)
    unsigned char* ws = C.ws;
    bf16* HB = (bf16*)(ws + WS_H); bf16* OUTB = (bf16*)(ws + WS_OUT); bf16* ACTB = (bf16*)(ws + WS_ACT);
    bf16* QB = (bf16*)(ws + WS_Q); bf16* KB = (bf16*)(ws + WS_K); bf16* VB = (bf16*)(ws + WS_V); bf16* UB = (bf16*)(ws + WS_U);
    float* YB = (float*)(ws + WS_Y); float* XCTX = (float*)(ws + WS_XCTX); float* PARTB = (float*)(ws + WS_PART);
    const float* x_in = C.in[0]; const float* ctx_in = C.in[2];
#define WIN(i) ((const bf16*)(ws + WS_WIN + (size_t)(i) * WIN_STRIDE))
#define WOUT(i) ((const bf16*)(ws + WS_WOUT + (size_t)(i) * WOUT_STRIDE))
#define GEMM_PHASE(EPI_T, EPI, Aptr, Btptr, M_, N_, K_) GEMM_PHASE_W(EPI_T, EPI, Aptr, Btptr, M_, N_, K_, 8)
#define GEMM_PHASE_W(EPI_T, EPI, Aptr, Btptr, M_, N_, K_, WGM_) do { pg8::Gemm g_{(Aptr), (Btptr), (M_), (N_), (K_), (K_), 0}; pg8::StaticOrder S_; S_.init((M_), (N_), C.G, (int)blockIdx.x, (WGM_) & 15, (WGM_) >> 4); \
        pg8::gemm_phase<EPI_T, pg8::StaticOrder, true, true>(C.lds, g_, S_, (EPI)); } while (0)

#define GEMM_CTX_SPLITK(Aptr, Btptr, N_, K_, NKS_) do { pg8::Gemm g_{(Aptr), (Btptr), MALL, (N_), (K_) / (NKS_), (K_), (K_) / (NKS_)}; pg8::SplitKOrder S_; S_.init(MLAT / 256, MCTX / 256, (N_), (NKS_), C.G, (int)blockIdx.x); \
        pg8::EpiPartial E_{PARTB, (N_), MLAT, (size_t)MCTX * (N_)}; pg8::gemm_phase<pg8::EpiPartial, pg8::SplitKOrder, true, true>(C.lds, g_, S_, E_); } while (0)
    if (IN(0)) { p0_prologue(C); } SEAM(0);
    if (IN(1)) { tv_build(C); xcd_barrier(bar); thin_phase(C, 0, false, 0, 0, 0, 0.f, true, 0, 0, 0, 1, 0, 0, MALL, 0); } SEAM(1);
    if (IN(2)) { pg8::EpiGated<0> E{ACTB, FF}; GEMM_PHASE(pg8::EpiGated<0>, E, HB, WIN(0), MALL, 2 * FF, D); filler_convert(C, CV_S2_B, CV_S2_E, (MALL / 256) * (2 * FF / 256) % 256); } SEAM(2);
    if (IN(3)) { pg8::EpiPlain E{OUTB, D}; GEMM_PHASE_W(pg8::EpiPlain, E, ACTB, WOUT(0), MLAT, D, FF, 4 + 16); GEMM_CTX_SPLITK(ACTB, WOUT(0), D, FF, 11); } SEAM(3);
    if (IN(4)) { thin_phase(C, 1, true, 0, 1, 2, 0.5f, true, 0, 2, 3, 4, 0, 1, MALL, 11); } SEAM(4);
    if (IN(5)) { pg8::EpiQKV E{QB, KB, VB, (const float*)(ws + WS_ROPE), 0.08838834764831845f * 1.4426950408889634f}; GEMM_PHASE(pg8::EpiQKV, E, HB, (const bf16*)(ws + WS_WQKV), MALL, 3072, D); filler_convert(C, CV_S5_B, CV_S5_E, (MALL / 256) * (3072 / 256) % 256); } SEAM(5);
    if (IN(6)) { attn_mfma(C, QB, KB, VB, C.in[11], HB, true); } SEAM(6);
    if (IN(7)) { pg8::EpiPlain E{OUTB, D}; GEMM_PHASE(pg8::EpiPlain, E, HB, (const bf16*)(ws + WS_WO), MLAT, D, D); GEMM_CTX_SPLITK(HB, (const bf16*)(ws + WS_WO), D, D, 4); } SEAM(7);
    if (IN(8)) { thin_phase(C, 2, true, 0, 3, 5, 1.0f, true, 0, 4, 6, 7, 1, 1, MALL, 4); } SEAM(8);
    if (IN(9)) { pg8::EpiGated<0> E{ACTB, FF}; GEMM_PHASE(pg8::EpiGated<0>, E, HB, WIN(1), MALL, 2 * FF, D); filler_convert(C, CV_S9_B, CV_S9_E, (MALL / 256) * (2 * FF / 256) % 256); } SEAM(9);
    if (IN(10)) { pg8::EpiPlain E{OUTB, D}; GEMM_PHASE_W(pg8::EpiPlain, E, ACTB, WOUT(1), MLAT, D, FF, 4 + 16); GEMM_CTX_SPLITK(ACTB, WOUT(1), D, FF, 11); } SEAM(10);
    if (IN(11)) { thin_phase(C, 3, true, 0, 5, 8, 0.5f, true, 1, 0, 0, 1, 1, 1, MALL, 11); } SEAM(11);
    if (IN(12)) { pg8::EpiGated<0> E{ACTB, FF}; GEMM_PHASE(pg8::EpiGated<0>, E, HB, WIN(2), MALL, 2 * FF, D); filler_convert(C, CV_S12_B, CV_S12_E, (MALL / 256) * (2 * FF / 256) % 256); } SEAM(12);
    if (IN(13)) { pg8::EpiPlain E{OUTB, D}; GEMM_PHASE_W(pg8::EpiPlain, E, ACTB, WOUT(2), MLAT, D, FF, 4 + 16); GEMM_CTX_SPLITK(ACTB, WOUT(2), D, FF, 11); } SEAM(13);
    if (IN(14)) { thin_phase(C, 4, true, 1, 1, 2, 0.5f, true, 1, 2, 3, 4, 1, 1, MALL, 11); } SEAM(14);
    if (IN(15)) { pg8::EpiUg E{UB}; GEMM_PHASE(pg8::EpiUg, E, HB, (const bf16*)(ws + WS_WSIN), MALL, D, D); filler_convert(C, CV_S15_B, CV_S15_E, (MALL / 256) * (D / 256) % 256); } SEAM(15);
    if (IN(16)) { ssm_phase(C, UB, YB, HB); } SEAM(16);
    if (IN(17)) { pg8::EpiGated<1> E{OUTB, D}; GEMM_PHASE(pg8::EpiGated<1>, E, HB, (const bf16*)(ws + WS_WGLU), MLAT, 4096, D); } SEAM(17);
    if (IN(18)) { thin_phase(C, 5, true, 1, 3, 5, 1.0f, true, 1, 4, 6, 7, 1, 1, MLAT, 0); } SEAM(18);
    if (IN(19)) { pg8::EpiGated<0> E{ACTB, FF}; GEMM_PHASE(pg8::EpiGated<0>, E, HB, WIN(3), MLAT, 2 * FF, D); } SEAM(19);
    if (IN(20)) { pg8::EpiPlain E{OUTB, D}; GEMM_PHASE_W(pg8::EpiPlain, E, ACTB, WOUT(3), MLAT, D, FF, 4 + 16); } SEAM(20);
    if (IN(21)) { thin_phase(C, 6, true, 1, 5, 8, 0.5f, false, 0, 0, 0, 0, 1, 2, MLAT, 0); }
#undef IN
#undef SEAM
}

extern "C" void kernel_launch(void* const* d_in, const int* in_sizes, int n_in, void* d_out, int out_size, void* d_ws, size_t ws_size, hipStream_t stream) {
    static int grid = 0;
    if (grid == 0) {
        if (n_in != 22 || out_size != MLAT * D || ws_size < WS_END) { fprintf(stderr, "kernel_launch: unexpected shapes (n_in %d, out %d, ws %zu)\n", n_in, out_size, ws_size); grid = -1; return; }
        int dev = 0, cus = 0, per_cu = 0;
        if (hipGetDevice(&dev) != hipSuccess || hipDeviceGetAttribute(&cus, hipDeviceAttributeMultiprocessorCount, dev) != hipSuccess) { grid = -1; return; }
        if (hipFuncSetAttribute((const void*)fwd_kernel, hipFuncAttributeMaxDynamicSharedMemorySize, LDS_BYTES) != hipSuccess) { fprintf(stderr, "kernel_launch: hipFuncSetAttribute failed\n"); grid = -1; return; }
        if (hipOccupancyMaxActiveBlocksPerMultiprocessor(&per_cu, (const void*)fwd_kernel, NWAVES * 64, LDS_BYTES) != hipSuccess || per_cu < 1) fprintf(stderr, "kernel_launch: occupancy query says %d\n", per_cu);
        (void)hipGetLastError();
        grid = cus;
    }
    if (grid < 0) return;
    (void)hipMemsetAsync((char*)d_ws + WS_CTL, 0, CTL_ZERO_BYTES, stream);
    Args a{};
    for (int i = 0; i < 22; ++i) a.in[i] = (const float*)d_in[i];
    a.out = (float*)d_out; a.ws = (unsigned char*)d_ws;
#if MK_ONE_LAUNCH
    a.ph_lo = 0; a.ph_hi = NPHASE;
    hipLaunchKernelGGL(fwd_kernel, dim3(grid), dim3(NWAVES * 64), LDS_BYTES, stream, a);
#else
    for (int p = 0; p < NPHASE; ++p) { a.ph_lo = p; a.ph_hi = p + 1; hipLaunchKernelGGL(fwd_kernel, dim3(grid), dim3(NWAVES * 64), LDS_BYTES, stream, a); }
#endif
}
```
